# Optimizing an MI355X kernel written in HIP

```python
import math
import jax
import jax.numpy as jnp
from jax import lax
import numpy as np

D_MODEL = 1024
BATCH = 8
SEQ = 4096
DEPTH = 2

N_BRANCH = 4
BRANCH_W = 512
SSD_HEADS = 8
SSD_HEAD_DIM = 64
SSD_GROUPS = 2
SSD_STATE = 128
SSD_CHUNK = 128
SSD_CONV = 4
SSD_XBC = BRANCH_W + 2 * SSD_GROUPS * SSD_STATE
DN_HEADS = 4
DN_HEAD_DIM = 128
DN_CHUNK = 64
DN_CONV = 4
SG_GROUPS = 4
SG_GROUP_DIM = BRANCH_W // SG_GROUPS
SG_CHUNK = 128
FOX_HEADS = 8
FOX_HEAD_DIM = 64
FOX_BLOCK = 128
D_FF = 4 * D_MODEL
IN_SIZES = (BRANCH_W, SSD_XBC, SSD_HEADS, 3 * BRANCH_W, DN_HEADS, DN_HEADS, BRANCH_W,
            2 * BRANCH_W, 3 * BRANCH_W, FOX_HEADS, N_BRANCH * D_MODEL)
D_IN = sum(IN_SIZES)
LN_EPS = 1e-5
NORM_EPS = 1e-6
DEEPNORM_ALPHA = (2 * DEPTH) ** 0.25
DEEPNORM_BETA = (8 * DEPTH) ** -0.25

kernel_name = "hybrid_ssd_deltanet_sgmlp_fox"


def layer_norm(x, g, b):
    xf = x.astype(jnp.float32)
    mu = jnp.mean(xf, -1, keepdims=True)
    var = jnp.mean(jnp.square(xf - mu), -1, keepdims=True)
    y = (xf - mu) * lax.rsqrt(var + LN_EPS) * g.astype(jnp.float32) + b.astype(jnp.float32)
    return y.astype(x.dtype)


def rms_norm(x, w):
    xf = x.astype(jnp.float32)
    return xf * lax.rsqrt(jnp.mean(xf * xf, -1, keepdims=True) + NORM_EPS) * w.astype(jnp.float32)


def l2_normalize(t):
    return t * lax.rsqrt(jnp.sum(t * t, -1, keepdims=True) + NORM_EPS)


def causal_dwconv(x, w):
    k = w.shape[0]
    return lax.conv_general_dilated(x, w[:, None, :], window_strides=(1,), padding=[(k - 1, 0)],
                                    dimension_numbers=('NWC', 'WIO', 'NWC'),
                                    feature_group_count=x.shape[-1])


def ssd_mixer(z, xbc, dt_raw, conv_w, conv_b, dt_bias, a_log, d_skip, norm_w):
    f32 = jnp.float32
    b, L, _ = z.shape
    nc, Q, G = L // SSD_CHUNK, SSD_CHUNK, SSD_GROUPS
    e = SSD_HEADS // G
    xbc = jax.nn.silu(causal_dwconv(xbc, conv_w) + conv_b)
    xs, bm, cm = jnp.split(xbc.astype(f32), [BRANCH_W, BRANCH_W + G * SSD_STATE], axis=-1)
    dt = jax.nn.softplus(dt_raw.astype(f32) + dt_bias.astype(f32))
    a = -jnp.exp(a_log.astype(f32))
    xh = xs.reshape(b, nc, Q, G, e, SSD_HEAD_DIM)
    xdt = xh * dt.reshape(b, nc, Q, G, e)[..., None]
    bm = bm.reshape(b, nc, Q, G, SSD_STATE)
    cm = cm.reshape(b, nc, Q, G, SSD_STATE)
    a_cs = jnp.cumsum((dt * a).reshape(b, nc, Q, G, e).transpose(0, 3, 4, 1, 2), axis=-1)
    tri = jnp.tril(jnp.ones((Q, Q), bool))
    seg = jnp.exp(jnp.where(tri, a_cs[..., :, None] - a_cs[..., None, :], -jnp.inf))
    cb = jnp.einsum('bclgn,bcsgn->bgcls', cm, bm)
    y_diag = jnp.einsum('bgcls,bgecls,bcsgep->bclgep', cb, seg, xdt)
    decay_to_end = jnp.exp(a_cs[..., -1:] - a_cs)
    states = jnp.einsum('bcsgn,bgecs,bcsgep->cbgepn', bm, decay_to_end, xdt)
    chunk_decay = jnp.exp(a_cs[..., -1]).transpose(3, 0, 1, 2)

    def step(h, inp):
        st, dec = inp
        return h * dec[..., None, None] + st, h

    _, prev = lax.scan(step, jnp.zeros(states.shape[1:], f32), (states, chunk_decay))
    y_off = jnp.einsum('bclgn,cbgepn,bgecl->bclgep', cm, prev, jnp.exp(a_cs))
    y = y_diag + y_off + d_skip.astype(f32).reshape(G, e)[:, :, None] * xh
    y = y.reshape(b, L, BRANCH_W) * jax.nn.silu(z.astype(f32))
    return rms_norm(y, norm_w).astype(z.dtype)


def gated_deltanet_mixer(qkv, beta_raw, a_raw, gate, conv_w, a_log, dt_bias, norm_w):
    f32 = jnp.float32
    b, L, _ = qkv.shape
    H, Dk, C = DN_HEADS, DN_HEAD_DIM, DN_CHUNK
    nc = L // C
    qkv = jax.nn.silu(causal_dwconv(qkv, conv_w)).astype(f32)
    q, k, v = jnp.split(qkv, 3, axis=-1)
    q = l2_normalize(q.reshape(b, L, H, Dk)) * (Dk ** -0.5)
    k = l2_normalize(k.reshape(b, L, H, Dk))
    v = v.reshape(b, L, H, Dk)

    def chunk4(t):
        return t.reshape(b, nc, C, H, Dk).transpose(1, 0, 3, 2, 4)

    def chunk3(t):
        return t.reshape(b, nc, C, H).transpose(1, 0, 3, 2)

    q, k, v = chunk4(q), chunk4(k), chunk4(v)
    beta = chunk3(jax.nn.sigmoid(beta_raw.astype(f32)))
    g = -jnp.exp(a_log.astype(f32)) * jax.nn.softplus(a_raw.astype(f32) + dt_bias.astype(f32))
    g_cs = jnp.cumsum(chunk3(g), axis=-1)
    tri = jnp.tril(jnp.ones((C, C), bool))
    strict = jnp.tril(jnp.ones((C, C), f32), -1)
    gamma = jnp.exp(jnp.where(tri, g_cs[..., :, None] - g_cs[..., None, :], -jnp.inf))
    kb = k * beta[..., None]
    a_mat = jnp.einsum('nbhid,nbhjd->nbhij', kb, k) * gamma * strict
    m = a_mat + jnp.eye(C, dtype=f32)
    rhs = jnp.concatenate([kb * jnp.exp(g_cs)[..., None], v * beta[..., None]], axis=-1)
    sol = lax.linalg.triangular_solve(m, rhs, left_side=True, lower=True, unit_diagonal=True)
    w_c, u_c = jnp.split(sol, 2, axis=-1)
    qg = q * jnp.exp(g_cs)[..., None]
    qk = jnp.einsum('nbhid,nbhjd->nbhij', q, k) * gamma
    k_dec = k * jnp.exp(g_cs[..., -1:] - g_cs)[..., None]
    last = jnp.exp(g_cs[..., -1])

    def step(S, inp):
        qg_c, qk_c, w_i, u_i, kd_c, last_c = inp
        v_new = u_i - jnp.einsum('bhcd,bhde->bhce', w_i, S)
        o = jnp.einsum('bhcd,bhde->bhce', qg_c, S) + jnp.einsum('bhij,bhje->bhie', qk_c, v_new)
        S = S * last_c[..., None, None] + jnp.einsum('bhcd,bhce->bhde', kd_c, v_new)
        return S, o

    S0 = jnp.zeros((b, H, Dk, Dk), f32)
    _, o = lax.scan(step, S0, (qg, qk, w_c, u_c, k_dec, last))
    o = o.transpose(1, 0, 3, 2, 4).reshape(b, L, H, Dk)
    o = rms_norm(o, norm_w) * jax.nn.silu(gate.astype(f32).reshape(b, L, H, Dk))
    return o.reshape(b, L, BRANCH_W).astype(gate.dtype)


def spatial_gating_mixer(uv, ln_g, ln_b, w_s, b_s):
    b, L, _ = uv.shape
    nc = L // SG_CHUNK
    u, v = jnp.split(jax.nn.gelu(uv), 2, axis=-1)
    v = layer_norm(v, ln_g, ln_b).reshape(b, nc, SG_CHUNK, SG_GROUPS, SG_GROUP_DIM)
    w = w_s * jnp.tril(jnp.ones((SG_CHUNK, SG_CHUNK), w_s.dtype))
    v = jnp.einsum('gts,bcsgd->bctgd', w, v) + b_s.T[None, None, :, :, None]
    return u * v.reshape(b, L, BRANCH_W)


def forgetting_attention_mixer(qkv, f_raw, f_bias):
    f32 = jnp.float32
    b, L, _ = qkv.shape
    H, Dh, BLK = FOX_HEADS, FOX_HEAD_DIM, FOX_BLOCK
    nb = L // BLK
    q, k, v = (t.reshape(b, L, H, Dh) for t in jnp.split(qkv, 3, axis=-1))
    c = jnp.cumsum(jax.nn.log_sigmoid(f_raw.astype(f32) + f_bias.astype(f32)), axis=1)
    c_keys = c.transpose(0, 2, 1)
    qb = q.reshape(b, nb, BLK, H, Dh).transpose(1, 0, 2, 3, 4)
    cb = c.reshape(b, nb, BLK, H).transpose(1, 0, 3, 2)
    starts = jnp.arange(nb, dtype=jnp.int32) * BLK
    k_pos = jnp.arange(L, dtype=jnp.int32)
    scale = Dh ** -0.5

    def block(args):
        q_blk, c_blk, start = args
        s = jnp.einsum('bqhd,bkhd->bhqk', q_blk, k).astype(f32) * scale
        s = s + c_blk[..., None] - c_keys[:, :, None, :]
        q_pos = start + jnp.arange(BLK, dtype=jnp.int32)
        s = jnp.where(k_pos[None, :] <= q_pos[:, None], s, -jnp.inf)
        p = jax.nn.softmax(s, axis=-1)
        return jnp.einsum('bhqk,bkhd->bqhd', p.astype(v.dtype), v)

    o = lax.map(block, (qb, cb, starts))
    return o.transpose(1, 0, 2, 3, 4).reshape(b, L, BRANCH_W)


def setup_inputs(seed: int = 0) -> dict:
    key = jax.random.key(seed)
    ks = iter(jax.random.split(key, 40))
    f32 = jnp.float32

    def nrm(shape, scale):
        return scale * jax.random.normal(next(ks), shape, f32)

    def gain(shape):
        return 1.0 + nrm(shape, 0.02)

    def dt_bias_init(shape):
        u = jax.random.uniform(next(ks), shape, f32)
        dt = jnp.exp(u * (math.log(0.1) - math.log(0.001)) + math.log(0.001))
        return dt + jnp.log(-jnp.expm1(-dt))

    def a_log_init(shape):
        return jnp.log(jax.random.uniform(next(ks), shape, f32, minval=1.0, maxval=16.0))

    x = nrm((BATCH, SEQ, D_MODEL), 1.0)
    return {
        "x": x,
        "ln_in_g": gain((D_MODEL,)),
        "ln_in_b": nrm((D_MODEL,), 0.02),
        "w_in": nrm((DEPTH, D_MODEL, D_IN), D_MODEL ** -0.5),
        "ssd_conv_w": nrm((DEPTH, SSD_CONV, SSD_XBC), SSD_CONV ** -0.5),
        "ssd_conv_b": nrm((DEPTH, SSD_XBC), 0.02),
        "ssd_dt_bias": dt_bias_init((DEPTH, SSD_HEADS)),
        "ssd_a_log": a_log_init((DEPTH, SSD_HEADS)),
        "ssd_d": gain((DEPTH, SSD_HEADS)),
        "ssd_norm_w": gain((DEPTH, BRANCH_W)),
        "dn_conv_w": nrm((DEPTH, DN_CONV, 3 * BRANCH_W), DN_CONV ** -0.5),
        "dn_a_log": a_log_init((DEPTH, DN_HEADS)),
        "dn_dt_bias": dt_bias_init((DEPTH, DN_HEADS)),
        "dn_norm_w": gain((DEPTH, DN_HEAD_DIM)),
        "sg_ln_g": gain((DEPTH, BRANCH_W)),
        "sg_ln_b": nrm((DEPTH, BRANCH_W), 0.02),
        "sg_w": nrm((DEPTH, SG_GROUPS, SG_CHUNK, SG_CHUNK), SG_CHUNK ** -0.5),
        "sg_b": 1.0 + nrm((DEPTH, SG_GROUPS, SG_CHUNK), 0.1),
        "fox_f_bias": 2.0 + nrm((DEPTH, FOX_HEADS), 0.5),
        "gate_b": nrm((DEPTH, N_BRANCH, D_MODEL), 0.02),
        "w_branch": nrm((DEPTH, N_BRANCH, BRANCH_W, D_MODEL), BRANCH_W ** -0.5),
        "w_out": nrm((DEPTH, D_MODEL, D_MODEL), DEEPNORM_BETA * D_MODEL ** -0.5),
        "ln1_g": gain((DEPTH, D_MODEL)),
        "ln1_b": nrm((DEPTH, D_MODEL), 0.02),
        "w_up": nrm((DEPTH, D_MODEL, D_FF), D_MODEL ** -0.5),
        "w_down": nrm((DEPTH, D_FF, D_MODEL), DEEPNORM_BETA * D_FF ** -0.5),
        "ln2_g": gain((DEPTH, D_MODEL)),
        "ln2_b": nrm((DEPTH, D_MODEL), 0.02),
    }


def reference(x, ln_in_g, ln_in_b, w_in, ssd_conv_w, ssd_conv_b, ssd_dt_bias, ssd_a_log, ssd_d,
              ssd_norm_w, dn_conv_w, dn_a_log, dn_dt_bias, dn_norm_w, sg_ln_g, sg_ln_b, sg_w, sg_b,
              fox_f_bias, gate_b, w_branch, w_out, ln1_g, ln1_b, w_up, w_down, ln2_g, ln2_b):
    b, L, _ = x.shape
    splits = np.cumsum(IN_SIZES)[:-1].tolist()
    h = layer_norm(x, ln_in_g, ln_in_b)
    for l in range(DEPTH):
        proj = jnp.einsum('bld,dc->blc', h, w_in[l])
        (ssd_z, ssd_xbc, ssd_dt, dn_qkv, dn_beta, dn_a, dn_gate,
         sg_uv, fox_qkv, fox_f, gate_logits) = jnp.split(proj, splits, axis=-1)
        y_a = ssd_mixer(ssd_z, ssd_xbc, ssd_dt, ssd_conv_w[l], ssd_conv_b[l], ssd_dt_bias[l],
                        ssd_a_log[l], ssd_d[l], ssd_norm_w[l])
        y_b = gated_deltanet_mixer(dn_qkv, dn_beta, dn_a, dn_gate, dn_conv_w[l], dn_a_log[l],
                                   dn_dt_bias[l], dn_norm_w[l])
        y_c = spatial_gating_mixer(sg_uv, sg_ln_g[l], sg_ln_b[l], sg_w[l], sg_b[l])
        y_d = forgetting_attention_mixer(fox_qkv, fox_f, fox_f_bias[l])
        gates = jax.nn.sigmoid(gate_logits.reshape(b, L, N_BRANCH, D_MODEL) + gate_b[l])
        merged = gates[:, :, 0] * jnp.einsum('blc,cd->bld', y_a, w_branch[l, 0])
        merged = merged + gates[:, :, 1] * jnp.einsum('blc,cd->bld', y_b, w_branch[l, 1])
        merged = merged + gates[:, :, 2] * jnp.einsum('blc,cd->bld', y_c, w_branch[l, 2])
        merged = merged + gates[:, :, 3] * jnp.einsum('blc,cd->bld', y_d, w_branch[l, 3])
        mix = jnp.einsum('bld,de->ble', merged, w_out[l])
        h = layer_norm(DEEPNORM_ALPHA * h + mix, ln1_g[l], ln1_b[l])
        ff = jnp.einsum('blf,fd->bld', jnp.square(jax.nn.relu(jnp.einsum('bld,df->blf', h, w_up[l]))), w_down[l])
        h = layer_norm(DEEPNORM_ALPHA * h + ff, ln2_g[l], ln2_b[l])
    return h
```

```cpp
#include <hip/hip_runtime.h>
#include <hip/hip_cooperative_groups.h>
#include <cstdio>
#include <cstdint>
namespace cg = cooperative_groups;

typedef unsigned short bf16_t;
typedef short bf16x8 __attribute__((ext_vector_type(8)));
typedef float f32x4 __attribute__((ext_vector_type(4)));
typedef float f32x16 __attribute__((ext_vector_type(16)));
typedef unsigned u32x4 __attribute__((ext_vector_type(4)));
typedef unsigned u32x2 __attribute__((ext_vector_type(2)));

constexpr int NT = 512;
constexpr int MTOK = 32768, SEQL = 4096, DM = 1024, DFF = 4096;
constexpr int DIN = 10264;
constexpr int NPROJ = 6400;
constexpr int NWIN = 6400 + 4096;
constexpr size_t LDS_BYTES = 163840;
constexpr float ALPHA = 1.4142135623730951f;

struct Params {
  const float* x; const float* ln_in_g; const float* ln_in_b; const float* w_in;
  const float* ssd_conv_w; const float* ssd_conv_b; const float* ssd_dt_bias; const float* ssd_a_log; const float* ssd_d; const float* ssd_norm_w;
  const float* dn_conv_w; const float* dn_a_log; const float* dn_dt_bias; const float* dn_norm_w;
  const float* sg_ln_g; const float* sg_ln_b; const float* sg_w; const float* sg_b;
  const float* fox_f_bias; const float* gate_b; const float* w_branch; const float* w_out;
  const float* ln1_g; const float* ln1_b; const float* w_up; const float* w_down; const float* ln2_g; const float* ln2_b;
  float* hf;
  unsigned* ctrl;
  bf16_t* hb;
  bf16_t* Z;
  bf16_t* XBC;
  bf16_t* DNQKV;
  bf16_t* DNG;
  bf16_t* SGUV;
  bf16_t* FOXQKV;
  float* small;
  float* cbuf;
  float* ssqp;
  bf16_t* halo;
  bf16_t* WinT;
  bf16_t* WbT;
  bf16_t* WoT;
  bf16_t* WupT;
  bf16_t* WdnT;
  bf16_t* U;
};

typedef float f32x2_t __attribute__((ext_vector_type(2)));
typedef __bf16 bf16x2_t __attribute__((ext_vector_type(2)));
__device__ __forceinline__ unsigned pk_bf16(float lo, float hi) { f32x2_t v = {lo, hi}; bf16x2_t b = __builtin_convertvector(v, bf16x2_t); unsigned r; __builtin_memcpy(&r, &b, 4); return r; }
__device__ __forceinline__ bf16_t f2bf(float x) { return (bf16_t)(pk_bf16(x, 0.f) & 0xffffu); }
__device__ __forceinline__ float bf2f(bf16_t x) { return __uint_as_float(((unsigned)x) << 16); }
__device__ __forceinline__ float bflo(unsigned w) { return __uint_as_float(w << 16); }
__device__ __forceinline__ float bfhi(unsigned w) { return __uint_as_float(w & 0xffff0000u); }
__device__ __forceinline__ float sigmoidf_(float x) { return 1.f / (1.f + __expf(-x)); }
__device__ __forceinline__ float siluf_(float x) { return x / (1.f + __expf(-x)); }
__device__ __forceinline__ float softplusf_(float x) { return fmaxf(x, 0.f) + log1pf(__expf(-fabsf(x))); }
__device__ __forceinline__ float logsigmoidf_(float x) { return fminf(x, 0.f) - log1pf(__expf(-fabsf(x))); }
__device__ __forceinline__ float geluf_(float x) {
  const float y = 0.7978845608028654f * (x + 0.044715f * x * x * x);
  const float t = 1.f - 2.f / (__expf(2.f * y) + 1.f);
  return 0.5f * x * (1.f + t);
}
__device__ __forceinline__ int opq(int x) { asm("" : "+v"(x)); return x; }
__device__ __forceinline__ int tidx() { int t = threadIdx.x; asm volatile("" : "+v"(t)); return t; }
__device__ __forceinline__ int bidx() { int t = blockIdx.x; asm volatile("" : "+s"(t)); return t; }
__device__ __forceinline__ float wave_sum(float v) {
#pragma unroll
  for (int o = 32; o >= 1; o >>= 1) v += __shfl_xor(v, o);
  return v;
}
__device__ __forceinline__ f32x4 mma16(const bf16_t* P, int ldp, const bf16_t* Q, int ldq, int K, f32x4 acc, int lane) {
  const bf16_t* a = P + (lane & 15) * ldp + (lane >> 4) * 8;
  const bf16_t* b = Q + (lane & 15) * ldq + (lane >> 4) * 8;
  for (int k = 0; k < K; k += 32)
    acc = __builtin_amdgcn_mfma_f32_16x16x32_bf16(*(const bf16x8*)(a + k), *(const bf16x8*)(b + k), acc, 0, 0, 0);
  return acc;
}

template <int MI, int NI>
__device__ __forceinline__ void gemm_mainloop(const bf16_t* __restrict__ A, int lda, const bf16_t* __restrict__ Bt, int ldb, int K,
                                              char* lds, f32x16 (&acc)[MI][NI]) {
  constexpr int BM = 64 * MI, BN = 128 * NI, ACH = MI, BCH = 2 * NI, LDT = 72;
  constexpr int A_BYTES = BM * LDT * 2, B_BYTES = BN * LDT * 2, STAGE = A_BYTES + B_BYTES;
  const int tid = tidx(), lane = tid & 63, wave = tid >> 6, wm = wave >> 2, wn = wave & 3;
  u32x4 ra[ACH], rb[BCH];
  const int nk = K / 64;
  const int lrow = tid >> 3, lkc = (tid & 7) * 8;
  const bf16_t* ga = A + (size_t)lrow * lda + lkc;
  const bf16_t* gb = Bt + (size_t)lrow * ldb + lkc;
#pragma unroll
  for (int i = 0; i < ACH; ++i) ra[i] = *(const u32x4*)(ga + (size_t)(64 * i) * lda);
#pragma unroll
  for (int i = 0; i < BCH; ++i) rb[i] = *(const u32x4*)(gb + (size_t)(64 * i) * ldb);
  {
    char* base = lds;
#pragma unroll
    for (int i = 0; i < ACH; ++i) *(u32x4*)(base + ((lrow + 64 * i) * LDT + lkc) * 2) = ra[i];
#pragma unroll
    for (int i = 0; i < BCH; ++i) *(u32x4*)(base + A_BYTES + ((lrow + 64 * i) * LDT + lkc) * 2) = rb[i];
  }
  __syncthreads();
  const int aoff = ((wm * MI * 32 + (lane & 31)) * LDT + (lane >> 5) * 8) * 2;
  const int boff = A_BYTES + ((wn * NI * 32 + (lane & 31)) * LDT + (lane >> 5) * 8) * 2;
  for (int kt = 0; kt < nk; ++kt) {
    if (kt + 1 < nk) {
#pragma unroll
      for (int i = 0; i < ACH; ++i) ra[i] = *(const u32x4*)(ga + (size_t)(64 * i) * lda + (kt + 1) * 64);
#pragma unroll
      for (int i = 0; i < BCH; ++i) rb[i] = *(const u32x4*)(gb + (size_t)(64 * i) * ldb + (kt + 1) * 64);
    }
    const char* st = lds + (kt & 1) * STAGE;
#pragma unroll
    for (int k16 = 0; k16 < 4; ++k16) {
      bf16x8 a[MI], b[NI];
#pragma unroll
      for (int mi = 0; mi < MI; ++mi) a[mi] = *(const bf16x8*)(st + aoff + (mi * 32 * LDT + k16 * 16) * 2);
#pragma unroll
      for (int ni = 0; ni < NI; ++ni) b[ni] = *(const bf16x8*)(st + boff + (ni * 32 * LDT + k16 * 16) * 2);
#pragma unroll
      for (int mi = 0; mi < MI; ++mi)
#pragma unroll
        for (int ni = 0; ni < NI; ++ni) acc[mi][ni] = __builtin_amdgcn_mfma_f32_32x32x16_bf16(b[ni], a[mi], acc[mi][ni], 0, 0, 0);
    }
    if (kt + 1 < nk) {
      char* base = lds + ((kt + 1) & 1) * STAGE;
#pragma unroll
      for (int i = 0; i < ACH; ++i) *(u32x4*)(base + ((lrow + 64 * i) * LDT + lkc) * 2) = ra[i];
#pragma unroll
      for (int i = 0; i < BCH; ++i) *(u32x4*)(base + A_BYTES + ((lrow + 64 * i) * LDT + lkc) * 2) = rb[i];
    }
    __syncthreads();
  }
}
template <int MI, int NI>
__device__ __forceinline__ void zero_acc(f32x16 (&acc)[MI][NI]) {
#pragma unroll
  for (int mi = 0; mi < MI; ++mi)
#pragma unroll
    for (int ni = 0; ni < NI; ++ni)
#pragma unroll
      for (int r = 0; r < 16; ++r) acc[mi][ni][r] = 0.f;
}

namespace pg8 {
#define PG8_LAS __attribute__((address_space(3)))
constexpr int BM = 256, BK = 64, HALF = 128, HTB = HALF * BK * 2  , STAGE_BYTES = 8 * HTB, NXCD = 8, WGM = 8;

__host__ __device__ __forceinline__ int lds_byte(int r, int c) { const int st = (r >> 4) * 2 + (c >> 5), rr = r & 15, cc = c & 31, ob = rr * 64 + cc * 2; return st * 1024 + (ob ^ (((ob >> 9) & 1) << 5)); }
__host__ __device__ __forceinline__ void stage_rc(int b, int& R, int& C) { const int st = b / 1024, sb = b % 1024, swz = sb ^ (((sb >> 9) & 1) << 5); R = (st >> 1) * 16 + swz / 64; C = (st & 1) * 32 + (swz % 64) / 2; }
__host__ __device__ __forceinline__ int perm32(int rho) { const int n = rho >> 4, i = rho & 15; return 8 * (i >> 2) + 4 * n + (i & 3); }
struct Unit { int pm, pn; };
struct Gemm { const bf16_t* A; const bf16_t* Bt; int M, N, K; };

struct StaticOrder {
    int nM, nN, nwg, G, c;
    __host__ __device__ void init(int M, int N, int G_, int c_) { nM = M / BM; nN = N / BM; nwg = nM * nN; G = G_; c = c_; }
    __host__ __device__ bool next(int i, Unit& u) const {
        const long L = (long)i * G + c; if (L >= nwg) return false;
        int wgid = (int)L; { const int q = nwg / NXCD, r = nwg % NXCD, xcd = wgid % NXCD, off = wgid / NXCD; wgid = (xcd < r ? xcd * (q + 1) : r * (q + 1) + (xcd - r) * q) + off; }
        const int nig = WGM * nN, gid = wgid / nig, fm = gid * WGM, gsz = (nM - fm) < WGM ? (nM - fm) : WGM;
        u.pm = fm + ((wgid % nig) % gsz); u.pn = (wgid % nig) / gsz; return true;
    }
    __device__ __forceinline__ void a_ready(const Unit&) const {}
    __device__ __forceinline__ void done(const Unit&) const {}
};
template <class Epi, class Sched, bool ALIGN_EPI = false, bool SP2 = false>
__device__ __forceinline__ void gemm_phase(PG8_LAS unsigned char* lds, const Gemm g, const Sched& S, const Epi& E) {
    const int tid = tidx(), wid = __builtin_amdgcn_readfirstlane(tid >> 6), lane = tid & 63, wr = wid >> 2, wc = wid & 3, fr = lane & 15, fq = lane >> 4;
    const int K = g.K, nt = K / BK;
    unsigned voffA[2], voffB[2];
#pragma unroll
    for (int i = 0; i < 2; ++i) { int R, C; stage_rc(tid * 16 + i * 8192, R, C); const int Rb = Epi::PERM ? ((R & ~31) + perm32(R & 31)) : R;
        voffA[i] = (unsigned)(R * K + C) * 2u; voffB[i] = (unsigned)(Rb * K + C) * 2u; }
    const size_t kstep = (size_t)(BK * 2);
    const size_t hstep = (size_t)HALF * K * 2;
    const size_t tstep = 2 * hstep;
    const unsigned ldsw = (unsigned)wid * 1024u;
    const int aoff = lds_byte(wr * 64 + fr, fq * 8), boff = lds_byte(wc * 32 + fr, fq * 8);
#define PG8_SA(b, h) (((b) * 2 + (h)) * HTB)
#define PG8_SB(b, h) ((4 + (b) * 2 + (h)) * HTB)
#define PG8_STAGE(bufoff, gbase, voff) do { _Pragma("unroll") for (int _i = 0; _i < 2; ++_i) \
        __builtin_amdgcn_global_load_lds((const unsigned*)((const char*)(gbase) + (voff)[_i]), (PG8_LAS unsigned*)(lds + (bufoff) + ldsw + _i * 8192), 16, 0, 0); } while (0)
#define PG8_LDA(dst, b, h) do { _Pragma("unroll") for (int m = 0; m < 4; ++m) _Pragma("unroll") for (int k = 0; k < 2; ++k) dst[m][k] = *(const PG8_LAS bf16x8*)(lds + PG8_SA(b, h) + aoff + m * 2048 + k * 1024); } while (0)
#define PG8_LDB(dst, b, h) do { _Pragma("unroll") for (int n = 0; n < 2; ++n) _Pragma("unroll") for (int k = 0; k < 2; ++k) dst[n][k] = *(const PG8_LAS bf16x8*)(lds + PG8_SB(b, h) + boff + n * 2048 + k * 1024); } while (0)
#define PG8_MMA(ai, bj, At, Bt) do { __builtin_amdgcn_s_setprio(1); _Pragma("unroll") for (int m = 0; m < 4; ++m) _Pragma("unroll") for (int n = 0; n < 2; ++n) _Pragma("unroll") for (int k = 0; k < 2; ++k) \
        acc[ai][bj][m][n] = __builtin_amdgcn_mfma_f32_16x16x32_bf16(Bt[n][k], At[m][k], acc[ai][bj][m][n], 0, 0, 0); __builtin_amdgcn_s_setprio(0); } while (0)
#define PG8_WAIT_V(n) asm volatile("s_waitcnt vmcnt(" #n ")" ::: "memory")
#define PG8_WAIT_L(n) asm volatile("s_waitcnt lgkmcnt(" #n ")" ::: "memory")
#define PG8_BAR __builtin_amdgcn_s_barrier()
#define PG8_SCHED __builtin_amdgcn_sched_barrier(0)
    Unit cur, nxt; int ui = 0;
    if (!S.next(0, cur)) return;
    f32x4 acc[2][2][4][2];
#pragma unroll
    for (int a = 0; a < 2; ++a)
#pragma unroll
        for (int b = 0; b < 2; ++b)
#pragma unroll
            for (int m = 0; m < 4; ++m)
#pragma unroll
                for (int n = 0; n < 2; ++n) acc[a][b][m][n] = (f32x4){0.f, 0.f, 0.f, 0.f};
    bf16x8 At[4][2], B0[2][2], B1[2][2];
    const char* cA = (const char*)g.A + (size_t)cur.pm * tstep; const char* cB = (const char*)g.Bt + (size_t)cur.pn * tstep;
    S.a_ready(cur);
    if constexpr (SP2) {
        PG8_STAGE(PG8_SB(0, 0), cB, voffB); PG8_STAGE(PG8_SB(0, 1), cB + hstep, voffB); PG8_STAGE(PG8_SA(0, 0), cA, voffA); PG8_STAGE(PG8_SA(0, 1), cA + hstep, voffA);
        if (wr == 1) PG8_BAR;
        PG8_WAIT_V(2); PG8_BAR;
        PG8_STAGE(PG8_SB(1, 0), cB + kstep, voffB); PG8_STAGE(PG8_SA(1, 0), cA + kstep, voffA); PG8_STAGE(PG8_SB(1, 1), cB + hstep + kstep, voffB);
        PG8_WAIT_V(6); PG8_BAR;
    } else {
        PG8_STAGE(PG8_SB(0, 0), cB, voffB); PG8_STAGE(PG8_SA(0, 0), cA, voffA); PG8_STAGE(PG8_SB(0, 1), cB + hstep, voffB); PG8_STAGE(PG8_SA(0, 1), cA + hstep, voffA);
        if (wr == 1) PG8_BAR;
        PG8_WAIT_V(4); PG8_BAR;
        PG8_STAGE(PG8_SB(1, 0), cB + kstep, voffB); PG8_STAGE(PG8_SA(1, 0), cA + kstep, voffA); PG8_STAGE(PG8_SB(1, 1), cB + hstep + kstep, voffB);
        PG8_WAIT_V(6); PG8_BAR;
    }
    for (;;) {
        const bool has_next = S.next(ui + 1, nxt);
        const char* nA = has_next ? (const char*)g.A + (size_t)nxt.pm * tstep : cA; const char* nB = has_next ? (const char*)g.Bt + (size_t)nxt.pn * tstep : cB;
        for (int t = 0; t < nt; t += 2) {
            const bool last = (t == nt - 2);
            const char* a1 = cA + (size_t)(t + 1) * kstep;
            const char* a2 = last ? nA : cA + (size_t)(t + 2) * kstep; const char* b2 = last ? nB : cB + (size_t)(t + 2) * kstep;
            const char* a3 = a2 + kstep; const char* b3 = b2 + kstep;
            if (last && has_next) S.a_ready(nxt);
            if constexpr (SP2) {
            PG8_LDB(B0, 0, 0); PG8_LDB(B1, 0, 1); PG8_SCHED; PG8_LDA(At, 0, 0); PG8_STAGE(PG8_SA(1, 1), a1 + hstep, voffA);
            PG8_WAIT_V(8); PG8_WAIT_L(0); PG8_BAR; PG8_MMA(0, 0, At, B0); PG8_MMA(0, 1, At, B1); PG8_BAR; PG8_SCHED;
            PG8_LDA(At, 0, 1); PG8_STAGE(PG8_SB(0, 0), b2, voffB); PG8_STAGE(PG8_SB(0, 1), b2 + hstep, voffB); PG8_STAGE(PG8_SA(0, 0), a2, voffA);
            PG8_WAIT_V(8); PG8_WAIT_L(0); PG8_BAR; PG8_MMA(1, 0, At, B0); PG8_MMA(1, 1, At, B1); PG8_BAR; PG8_SCHED;
            PG8_LDB(B0, 1, 0); PG8_LDB(B1, 1, 1); PG8_SCHED; PG8_LDA(At, 1, 0); PG8_STAGE(PG8_SA(0, 1), a2 + hstep, voffA);
            PG8_WAIT_V(8); PG8_WAIT_L(0); PG8_BAR; PG8_MMA(0, 0, At, B0); PG8_MMA(0, 1, At, B1); PG8_BAR; PG8_SCHED;
            PG8_LDA(At, 1, 1); PG8_STAGE(PG8_SB(1, 0), b3, voffB); PG8_STAGE(PG8_SB(1, 1), b3 + hstep, voffB); PG8_STAGE(PG8_SA(1, 0), a3, voffA);
            PG8_WAIT_V(8); PG8_WAIT_L(0); PG8_BAR; PG8_MMA(1, 0, At, B0); PG8_MMA(1, 1, At, B1); PG8_BAR; PG8_SCHED;
            } else {
            PG8_LDB(B0, 0, 0); PG8_SCHED; PG8_LDA(At, 0, 0); PG8_STAGE(PG8_SA(1, 1), a1 + hstep, voffA);
            PG8_WAIT_L(8); PG8_BAR; PG8_WAIT_L(0); PG8_MMA(0, 0, At, B0); PG8_BAR; PG8_SCHED;
            PG8_LDB(B1, 0, 1); PG8_STAGE(PG8_SB(0, 0), b2, voffB);
            PG8_BAR; PG8_WAIT_L(0); PG8_MMA(0, 1, At, B1); PG8_BAR;
            PG8_LDA(At, 0, 1); PG8_STAGE(PG8_SA(0, 0), a2, voffA);
            PG8_BAR; PG8_WAIT_L(0); PG8_MMA(1, 0, At, B0); PG8_BAR; PG8_SCHED;
            PG8_STAGE(PG8_SB(0, 1), b2 + hstep, voffB);
            PG8_WAIT_V(6); PG8_BAR; PG8_MMA(1, 1, At, B1); PG8_BAR;
            PG8_LDB(B0, 1, 0); PG8_SCHED; PG8_LDA(At, 1, 0); PG8_STAGE(PG8_SA(0, 1), a2 + hstep, voffA);
            PG8_WAIT_L(8); PG8_BAR; PG8_WAIT_L(0); PG8_MMA(0, 0, At, B0); PG8_BAR; PG8_SCHED;
            PG8_LDB(B1, 1, 1); PG8_STAGE(PG8_SB(1, 0), b3, voffB);
            PG8_BAR; PG8_WAIT_L(0); PG8_MMA(0, 1, At, B1); PG8_BAR;
            PG8_LDA(At, 1, 1); PG8_STAGE(PG8_SA(1, 0), a3, voffA);
            PG8_BAR; PG8_WAIT_L(0); PG8_MMA(1, 0, At, B0); PG8_BAR; PG8_SCHED;
            PG8_STAGE(PG8_SB(1, 1), b3 + hstep, voffB);
            PG8_WAIT_V(6); PG8_BAR; PG8_MMA(1, 1, At, B1); PG8_BAR;
            }
        }
        if constexpr (ALIGN_EPI) { if (wr == 0) PG8_BAR; }
        if constexpr (!Epi::AFTER_DRAIN) { E(acc, cur, wr, wc, fr, fq); S.done(cur); }
        if (!has_next) break;
#pragma unroll
        for (int a = 0; a < 2; ++a)
#pragma unroll
            for (int b = 0; b < 2; ++b)
#pragma unroll
                for (int m = 0; m < 4; ++m)
#pragma unroll
                    for (int n = 0; n < 2; ++n) acc[a][b][m][n] = (f32x4){0.f, 0.f, 0.f, 0.f};
        cur = nxt; cA = nA; cB = nB; ++ui;
        if constexpr (ALIGN_EPI) { if (wr == 1) PG8_BAR; }
    }
    PG8_WAIT_V(0);
    if constexpr (!ALIGN_EPI) { if (wr == 0) PG8_BAR; }
    PG8_BAR;
    if constexpr (Epi::AFTER_DRAIN) { E.fused(acc, cur, wr, wc, fr, fq, lds, wid, lane); S.done(cur); }
#undef PG8_SA
#undef PG8_SB
#undef PG8_STAGE
#undef PG8_LDA
#undef PG8_LDB
#undef PG8_MMA
#undef PG8_WAIT_V
#undef PG8_WAIT_L
#undef PG8_BAR
#undef PG8_SCHED
}
}


template <int MI, int NI>
__device__ __forceinline__ void gemm_mainloop_dma(const bf16_t* __restrict__ A, int lda, const bf16_t* __restrict__ Bt, int ldb, int K,
                                                  PG8_LAS unsigned char* lds3, f32x16 (&acc)[MI][NI]) {
  constexpr int BM = 64 * MI, BN = 128 * NI;
  constexpr int A_BYTES = BM * 128, B_BYTES = BN * 128, STAGE = A_BYTES + B_BYTES;
  constexpr int APIECES = BM / 8 / 8, BPIECES = BN / 8 / 8;
  const int tid = tidx(), lane = tid & 63, wave = __builtin_amdgcn_readfirstlane(tid >> 6), wm = wave >> 2, wn = wave & 3;
  const int nk = K / 64;
  const int prow = lane >> 3;
  unsigned offA[APIECES], offB[BPIECES];
#pragma unroll
  for (int i = 0; i < APIECES; ++i) { const int row = (wave * APIECES + i) * 8 + prow; offA[i] = (unsigned)(row * lda + (((lane & 7) ^ ((row >> 1) & 7)) * 8)); }
#pragma unroll
  for (int i = 0; i < BPIECES; ++i) { const int row = (wave * BPIECES + i) * 8 + prow; offB[i] = (unsigned)(row * ldb + (((lane & 7) ^ ((row >> 1) & 7)) * 8)); }
  auto stage = [&](int st, int kt) {
    PG8_LAS unsigned char* base = lds3 + st * STAGE;
#pragma unroll
    for (int i = 0; i < APIECES; ++i)
      __builtin_amdgcn_global_load_lds((const unsigned*)(A + offA[i] + kt * 64), (PG8_LAS unsigned*)(base + (wave * APIECES + i) * 1024), 16, 0, 0);
#pragma unroll
    for (int i = 0; i < BPIECES; ++i)
      __builtin_amdgcn_global_load_lds((const unsigned*)(Bt + offB[i] + kt * 64), (PG8_LAS unsigned*)(base + A_BYTES + (wave * BPIECES + i) * 1024), 16, 0, 0);
  };
  stage(0, 0);
  asm volatile("s_waitcnt vmcnt(0)" ::: "memory");
  __builtin_amdgcn_s_barrier();
  const int ar = wm * MI * 32 + (lane & 31), br = wn * NI * 32 + (lane & 31), ch = lane >> 5;
  for (int kt = 0; kt < nk; ++kt) {
    if (kt + 1 < nk) stage((kt + 1) & 1, kt + 1);
    PG8_LAS const unsigned char* sa = lds3 + (kt & 1) * STAGE;
    PG8_LAS const unsigned char* sb = sa + A_BYTES;
#pragma unroll
    for (int k16 = 0; k16 < 4; ++k16) {
      bf16x8 a[MI], b[NI];
#pragma unroll
      for (int mi = 0; mi < MI; ++mi) { const int r = ar + mi * 32; a[mi] = *(PG8_LAS const bf16x8*)(sa + r * 128 + (((k16 * 2 + ch) ^ ((r >> 1) & 7)) * 16)); }
#pragma unroll
      for (int ni = 0; ni < NI; ++ni) { const int r = br + ni * 32; b[ni] = *(PG8_LAS const bf16x8*)(sb + r * 128 + (((k16 * 2 + ch) ^ ((r >> 1) & 7)) * 16)); }
#pragma unroll
      for (int mi = 0; mi < MI; ++mi)
#pragma unroll
        for (int ni = 0; ni < NI; ++ni) acc[mi][ni] = __builtin_amdgcn_mfma_f32_32x32x16_bf16(b[ni], a[mi], acc[mi][ni], 0, 0, 0);
    }
    asm volatile("s_waitcnt vmcnt(0) lgkmcnt(0)" ::: "memory");
    __builtin_amdgcn_s_barrier();
  }
}


template <int MI, int NI>
__device__ __forceinline__ void gemm_mainloop_dma128(const bf16_t* __restrict__ A, int lda, const bf16_t* __restrict__ Bt, int ldb, int K,
                                                     PG8_LAS unsigned char* lds3, f32x16 (&acc)[MI][NI]) {
  constexpr int BM = 64 * MI, BN = 128 * NI;
  constexpr int A_BYTES = BM * 256, B_BYTES = BN * 256, STAGE = A_BYTES + B_BYTES;
  constexpr int APIECES = BM / 4 / 8, BPIECES = BN / 4 / 8;
  const int tid = tidx(), lane = tid & 63, wave = __builtin_amdgcn_readfirstlane(tid >> 6), wm = wave >> 2, wn = wave & 3;
  const int nk = K / 128;
  const int prow = lane >> 4;
  unsigned offA[APIECES], offB[BPIECES];
#pragma unroll
  for (int i = 0; i < APIECES; ++i) { const int row = (wave * APIECES + i) * 4 + prow; offA[i] = (unsigned)(row * lda + (((lane & 15) ^ (row & 15)) * 8)); }
#pragma unroll
  for (int i = 0; i < BPIECES; ++i) { const int row = (wave * BPIECES + i) * 4 + prow; offB[i] = (unsigned)(row * ldb + (((lane & 15) ^ (row & 15)) * 8)); }
  auto stage = [&](int st, int kt) {
    PG8_LAS unsigned char* base = lds3 + st * STAGE;
#pragma unroll
    for (int i = 0; i < APIECES; ++i)
      __builtin_amdgcn_global_load_lds((const unsigned*)(A + offA[i] + kt * 128), (PG8_LAS unsigned*)(base + (wave * APIECES + i) * 1024), 16, 0, 0);
#pragma unroll
    for (int i = 0; i < BPIECES; ++i)
      __builtin_amdgcn_global_load_lds((const unsigned*)(Bt + offB[i] + kt * 128), (PG8_LAS unsigned*)(base + A_BYTES + (wave * BPIECES + i) * 1024), 16, 0, 0);
  };
  stage(0, 0);
  asm volatile("s_waitcnt vmcnt(0)" ::: "memory");
  __builtin_amdgcn_s_barrier();
  const int ar = wm * MI * 32 + (lane & 31), br = wn * NI * 32 + (lane & 31), ch = lane >> 5;
  for (int kt = 0; kt < nk; ++kt) {
    if (kt + 1 < nk) stage((kt + 1) & 1, kt + 1);
    PG8_LAS const unsigned char* sa = lds3 + (kt & 1) * STAGE;
    PG8_LAS const unsigned char* sb = sa + A_BYTES;
#pragma unroll
    for (int k16 = 0; k16 < 8; ++k16) {
      bf16x8 a[MI], b[NI];
#pragma unroll
      for (int mi = 0; mi < MI; ++mi) { const int r = ar + mi * 32; a[mi] = *(PG8_LAS const bf16x8*)(sa + r * 256 + (((k16 * 2 + ch) ^ (r & 15)) * 16)); }
#pragma unroll
      for (int ni = 0; ni < NI; ++ni) { const int r = br + ni * 32; b[ni] = *(PG8_LAS const bf16x8*)(sb + r * 256 + (((k16 * 2 + ch) ^ (r & 15)) * 16)); }
#pragma unroll
      for (int mi = 0; mi < MI; ++mi)
#pragma unroll
        for (int ni = 0; ni < NI; ++ni) acc[mi][ni] = __builtin_amdgcn_mfma_f32_32x32x16_bf16(b[ni], a[mi], acc[mi][ni], 0, 0, 0);
    }
    asm volatile("s_waitcnt vmcnt(0) lgkmcnt(0)" ::: "memory");
    __builtin_amdgcn_s_barrier();
  }
}

__device__ __forceinline__ int map_win(int n) {
  if (n < 1536) return n;
  if (n < 3072) return n + 8;
  if (n < 6144) return n + 16;
  if (n < 6400) { const int j = n - 6144; if (j < 8) return 1536 + j; if (j < 12) return 3080 + (j - 8); if (j < 16) return 3084 + (j - 12); if (j < 24) return 6160 + (j - 16); return -1; }
  return n - 6400 + 6168;
}
__device__ void convert_tile(const float* __restrict__ src, int ldsrc, int K, bf16_t* __restrict__ dst, int nb, int kb, bool win, float* ls) {
  const int tid = tidx();
  {
    const int n = tid & 63, kk = tid >> 6;
    const int nd = nb * 64 + n;
    const int col = win ? map_win(nd) : nd;
#pragma unroll
    for (int i = 0; i < 8; ++i) {
      const int k = kk + 8 * i;
      ls[k * 65 + n] = (col >= 0) ? src[(size_t)(kb * 64 + k) * ldsrc + col] : 0.f;
    }
  }
  __syncthreads();
  {
    const int n = tid >> 3, ks = (tid & 7) * 8;
    u32x4 w;
    w.x = pk_bf16(ls[(ks + 0) * 65 + n], ls[(ks + 1) * 65 + n]);
    w.y = pk_bf16(ls[(ks + 2) * 65 + n], ls[(ks + 3) * 65 + n]);
    w.z = pk_bf16(ls[(ks + 4) * 65 + n], ls[(ks + 5) * 65 + n]);
    w.w = pk_bf16(ls[(ks + 6) * 65 + n], ls[(ks + 7) * 65 + n]);
    *(u32x4*)(dst + (size_t)(nb * 64 + n) * K + kb * 64 + ks) = w;
  }
  __syncthreads();
}
__device__ void convert_weights(const Params& p, int layer, char* lds) {
  float* ls = (float*)lds;
  constexpr int T0 = 164 * 16, T1 = T0 + 4 * 16 * 8, T2 = T1 + 256, T3 = T2 + 1024, T4 = T3 + 1024;
  for (int t = bidx(); t < T4; t += gridDim.x) {
    if (t < T0) { convert_tile(p.w_in + (size_t)layer * DM * DIN, DIN, 1024, p.WinT, t >> 4, t & 15, true, ls); }
    else if (t < T1) { const int u = t - T0, br = u >> 7, v = u & 127; convert_tile(p.w_branch + ((size_t)(layer * 4 + br)) * 512 * 1024, 1024, 512, p.WbT + (size_t)br * 1024 * 512, v >> 3, v & 7, false, ls); }
    else if (t < T2) { const int u = t - T1; convert_tile(p.w_out + (size_t)layer * 1024 * 1024, 1024, 1024, p.WoT, u >> 4, u & 15, false, ls); }
    else if (t < T3) { const int u = t - T2; convert_tile(p.w_up + (size_t)layer * 1024 * 4096, 4096, 1024, p.WupT, u >> 4, u & 15, false, ls); }
    else { const int u = t - T3; convert_tile(p.w_down + (size_t)layer * 4096 * 1024, 1024, 4096, p.WdnT, u >> 6, u & 63, false, ls); }
  }
}

__device__ void ln_phase(const float* src, float* dstf, bf16_t* __restrict__ dstb, const float* __restrict__ g, const float* __restrict__ b) {
  const int lane = tidx() & 63, gw = bidx() * 8 + (tidx() >> 6), nw = gridDim.x * 8;
  f32x4 gv[4], bv[4];
#pragma unroll
  for (int i = 0; i < 4; ++i) { gv[i] = *(const f32x4*)(g + i * 256 + lane * 4); bv[i] = *(const f32x4*)(b + i * 256 + lane * 4); }
  for (int row = gw; row < MTOK; row += nw) {
    f32x4 v[4];
    float s = 0.f;
#pragma unroll
    for (int i = 0; i < 4; ++i) { v[i] = *(const f32x4*)(src + (size_t)row * DM + i * 256 + lane * 4); s += (v[i][0] + v[i][1]) + (v[i][2] + v[i][3]); }
    const float mu = wave_sum(s) * (1.f / 1024.f);
    float q = 0.f;
#pragma unroll
    for (int i = 0; i < 4; ++i) { v[i] = v[i] - mu; q += (v[i][0] * v[i][0] + v[i][1] * v[i][1]) + (v[i][2] * v[i][2] + v[i][3] * v[i][3]); }
    const float rstd = rsqrtf(wave_sum(q) * (1.f / 1024.f) + 1e-5f);
#pragma unroll
    for (int i = 0; i < 4; ++i) {
      f32x4 y = v[i] * rstd * gv[i] + bv[i];
      if (dstf) *(f32x4*)(dstf + (size_t)row * DM + i * 256 + lane * 4) = y;
      u32x2 w; w.x = pk_bf16(y[0], y[1]); w.y = pk_bf16(y[2], y[3]);
      *(u32x2*)(dstb + (size_t)row * DM + i * 256 + lane * 4) = w;
    }
  }
}

__device__ void inproj_phase(const Params& p, char* lds) {
  const int lane = tidx() & 63, wave = tidx() >> 6, wm = wave >> 2, wn = wave & 3;
  constexpr int NTN = NPROJ / 256;
  for (int t = bidx(); t < 128 * NTN; t += gridDim.x) {
    const int mt = t / NTN, nt = t % NTN, n0 = nt * 256;
    f32x16 acc[4][2];
    zero_acc<4, 2>(acc);
    gemm_mainloop<4, 2>(p.hb + (size_t)mt * 256 * DM, DM, p.WinT + (size_t)n0 * DM, DM, DM, lds, acc);
    bf16_t* dst; int ld, off;
    if (n0 < 512) { dst = p.Z; ld = 512; off = n0; }
    else if (n0 < 1536) { dst = p.XBC; ld = 1024; off = n0 - 512; }
    else if (n0 < 3072) { dst = p.DNQKV; ld = 1536; off = n0 - 1536; }
    else if (n0 < 3584) { dst = p.DNG; ld = 512; off = n0 - 3072; }
    else if (n0 < 4608) { dst = p.SGUV; ld = 1024; off = n0 - 3584; }
    else if (n0 < 6144) { dst = p.FOXQKV; ld = 1536; off = n0 - 4608; }
    else { dst = nullptr; ld = 0; off = 0; }
#pragma unroll
    for (int mi = 0; mi < 4; ++mi) {
      const int m = mt * 256 + wm * 128 + mi * 32 + (lane & 31);
#pragma unroll
      for (int ni = 0; ni < 2; ++ni)
#pragma unroll
        for (int q = 0; q < 4; ++q) {
          const int n = wn * 64 + ni * 32 + q * 8 + (lane >> 5) * 4;
          if (dst) {
            u32x2 w; w.x = pk_bf16(acc[mi][ni][q * 4 + 0], acc[mi][ni][q * 4 + 1]); w.y = pk_bf16(acc[mi][ni][q * 4 + 2], acc[mi][ni][q * 4 + 3]);
            *(u32x2*)(dst + (size_t)m * ld + off + n) = w;
          } else if (n < 32) {
            f32x4 v = {acc[mi][ni][q * 4 + 0], acc[mi][ni][q * 4 + 1], acc[mi][ni][q * 4 + 2], acc[mi][ni][q * 4 + 3]};
            *(f32x4*)(p.small + (size_t)m * 32 + n) = v;
          }
        }
    }
  }
}


struct EpiProj {
  static constexpr bool PERM = true, AFTER_DRAIN = false;
  Params p;
  __device__ __forceinline__ void operator()(const f32x4 (&acc)[2][2][4][2], const pg8::Unit& u, int wr, int wc, int fr, int fq) const {
    const int n0 = u.pn * 256;
    bf16_t* dst; int ld, off;
    if (n0 < 512) { dst = p.Z; ld = 512; off = n0; }
    else if (n0 < 1536) { dst = p.XBC; ld = 1024; off = n0 - 512; }
    else if (n0 < 3072) { dst = p.DNQKV; ld = 1536; off = n0 - 1536; }
    else if (n0 < 3584) { dst = p.DNG; ld = 512; off = n0 - 3072; }
    else if (n0 < 4608) { dst = p.SGUV; ld = 1024; off = n0 - 3584; }
    else if (n0 < 6144) { dst = p.FOXQKV; ld = 1536; off = n0 - 4608; }
    else { dst = nullptr; ld = 0; off = 0; }
    const int hch = (n0 >= 512 && n0 < 1536) ? (n0 - 512) : (n0 >= 1536 && n0 < 3072) ? (1024 + n0 - 1536) : -1;
#pragma unroll
    for (int ai = 0; ai < 2; ++ai)
#pragma unroll
      for (int m = 0; m < 4; ++m) {
        const size_t r = (size_t)u.pm * 256 + ai * 128 + wr * 64 + m * 16 + fr;
#pragma unroll
        for (int bj = 0; bj < 2; ++bj) {
          const int c = bj * 128 + wc * 32 + fq * 8;
          const f32x4 v0 = acc[ai][bj][m][0], v1 = acc[ai][bj][m][1];
          if (dst) {
            u32x4 w; w.x = pk_bf16(v0[0], v0[1]); w.y = pk_bf16(v0[2], v0[3]); w.z = pk_bf16(v1[0], v1[1]); w.w = pk_bf16(v1[2], v1[3]);
            *(u32x4*)(dst + r * ld + off + c) = w;
            if (hch >= 0 && ((int)r & 63) >= 61) {
              const int rr = ((int)r >> 6) + 1;
              if (rr < 512 && (rr & 63) != 0) *(u32x4*)(p.halo + ((size_t)rr * 3 + (((int)r & 63) - 61)) * 2560 + hch + c) = w;
            }
          } else if (c < 32) {
            *(f32x4*)(p.small + r * 32 + c) = v0; *(f32x4*)(p.small + r * 32 + c + 4) = v1;
          }
        }
      }
  }
};
struct EpiUp {
  static constexpr bool PERM = true, AFTER_DRAIN = false;
  bf16_t* U;
  __device__ __forceinline__ void operator()(const f32x4 (&acc)[2][2][4][2], const pg8::Unit& u, int wr, int wc, int fr, int fq) const {
#pragma unroll
    for (int ai = 0; ai < 2; ++ai)
#pragma unroll
      for (int m = 0; m < 4; ++m) {
        const size_t r = (size_t)u.pm * 256 + ai * 128 + wr * 64 + m * 16 + fr;
#pragma unroll
        for (int bj = 0; bj < 2; ++bj) {
          const int c = u.pn * 256 + bj * 128 + wc * 32 + fq * 8;
          f32x4 v0 = acc[ai][bj][m][0], v1 = acc[ai][bj][m][1];
#pragma unroll
          for (int j = 0; j < 4; ++j) { v0[j] = fmaxf(v0[j], 0.f); v0[j] *= v0[j]; v1[j] = fmaxf(v1[j], 0.f); v1[j] *= v1[j]; }
          u32x4 w; w.x = pk_bf16(v0[0], v0[1]); w.y = pk_bf16(v0[2], v0[3]); w.z = pk_bf16(v1[0], v1[1]); w.w = pk_bf16(v1[2], v1[3]);
          *(u32x4*)(U + r * DFF + c) = w;
        }
      }
  }
};
struct EpiResid {
  static constexpr bool PERM = true, AFTER_DRAIN = false;
  float* hf; const bf16_t* hb;
  __device__ __forceinline__ void operator()(const f32x4 (&acc)[2][2][4][2], const pg8::Unit& u, int wr, int wc, int fr, int fq) const {
#pragma unroll
    for (int ai = 0; ai < 2; ++ai) {
#pragma unroll
      for (int m = 0; m < 4; ++m) {
        const size_t r = (size_t)u.pm * 256 + ai * 128 + wr * 64 + m * 16 + fr;
#pragma unroll
        for (int bj = 0; bj < 2; ++bj) {
          const int c = u.pn * 256 + bj * 128 + wc * 32 + fq * 8;
          const u32x4 hv = *(const u32x4*)(hb + r * DM + c);
          f32x4 a = {bflo(hv.x), bfhi(hv.x), bflo(hv.y), bfhi(hv.y)}, b = {bflo(hv.z), bfhi(hv.z), bflo(hv.w), bfhi(hv.w)};
          a = a * ALPHA + acc[ai][bj][m][0]; b = b * ALPHA + acc[ai][bj][m][1];
          float* hp = hf + r * DM + c;
          *(f32x4*)hp = a; *(f32x4*)(hp + 4) = b;
        }
      }
      asm volatile("" ::: "memory");
    }
  }
};
template <class Epi>
__device__ __forceinline__ void pg8_phase(const bf16_t* A, const bf16_t* Bt, int N, int K, const Epi& E, PG8_LAS unsigned char* lds3) {
  pg8::Gemm g; g.A = A; g.Bt = Bt; g.M = MTOK; g.N = N; g.K = K;
  pg8::StaticOrder S; S.init(MTOK, N, (int)gridDim.x, bidx());
  pg8::gemm_phase<Epi, pg8::StaticOrder, true, true>(lds3, g, S, E);
  __syncthreads();
}

__device__ void foxc_phase(const Params& p, int layer, char* lds) {
  float* wsum = (float*)lds;
  const int tid = tidx(), lane = tid & 63, wave = tid >> 6;
  for (int it = bidx(); it < 64; it += gridDim.x) {
    const int b = it >> 3, h = it & 7;
    const float fb = p.fox_f_bias[layer * 8 + h];
    float v[8]; float s = 0.f;
#pragma unroll
    for (int i = 0; i < 8; ++i) { const int l = tid * 8 + i; v[i] = logsigmoidf_(p.small[(size_t)(b * SEQL + l) * 32 + 16 + h] + fb); s += v[i]; }
    float inc = s;
#pragma unroll
    for (int o = 1; o < 64; o <<= 1) { const float t = __shfl_up(inc, o); if (lane >= o) inc += t; }
    if (lane == 63) wsum[wave] = inc;
    __syncthreads();
    float base = inc - s;
    for (int w = 0; w < wave; ++w) base += wsum[w];
    float c = base;
    float* out = p.cbuf + (size_t)it * SEQL + tid * 8;
#pragma unroll
    for (int i = 0; i < 8; ++i) { c += v[i]; out[i] = c; }
    float km = 0.f;
    for (int i = 0; i < 8; ++i) {
      const bf16_t* kp = p.FOXQKV + (size_t)(b * SEQL + tid * 8 + i) * 1536 + 512 + h * 64;
      float ss = 0.f;
#pragma unroll
      for (int c8 = 0; c8 < 8; ++c8) {
        const u32x4 r = *(const u32x4*)(kp + c8 * 8);
        ss += bflo(r.x) * bflo(r.x) + bfhi(r.x) * bfhi(r.x) + bflo(r.y) * bflo(r.y) + bfhi(r.y) * bfhi(r.y)
            + bflo(r.z) * bflo(r.z) + bfhi(r.z) * bfhi(r.z) + bflo(r.w) * bflo(r.w) + bfhi(r.w) * bfhi(r.w);
      }
      km = fmaxf(km, ss);
    }
#pragma unroll
    for (int o = 32; o >= 1; o >>= 1) km = fmaxf(km, __shfl_xor(km, o));
    __syncthreads();
    if (lane == 0) wsum[wave] = km;
    __syncthreads();
    if (tid == 0) { float m = wsum[0]; for (int w = 1; w < 8; ++w) m = fmaxf(m, wsum[w]); ((float*)(p.ctrl + 64))[it] = sqrtf(m); }
    __syncthreads();
  }
}

__device__ void gates_halo_phase(const Params& p, int layer) {
  const int tid = tidx(), lane = tid & 63, gw = bidx() * 8 + (tid >> 6), nw = (int)gridDim.x * 8;
  for (int task = gw; task < 512 * 12; task += nw) {
    const int r = task / 12, hh = task % 12;
    const size_t t = (size_t)r * 64 + lane;
    if (hh < 8) {
      const float dt = softplusf_(p.small[t * 32 + hh] + p.ssd_dt_bias[layer * 8 + hh]);
      float inc = dt * -__expf(p.ssd_a_log[layer * 8 + hh]);
#pragma unroll
      for (int o = 1; o < 64; o <<= 1) { const float v = __shfl_up(inc, o); if (lane >= o) inc += v; }
      p.small[t * 32 + hh] = dt; p.small[t * 32 + 24 + hh] = inc;
    } else {
      const int h = hh - 8;
      const float be = sigmoidf_(p.small[t * 32 + 8 + h]);
      float inc = -__expf(p.dn_a_log[layer * 4 + h]) * softplusf_(p.small[t * 32 + 12 + h] + p.dn_dt_bias[layer * 4 + h]);
#pragma unroll
      for (int o = 1; o < 64; o <<= 1) { const float v = __shfl_up(inc, o); if (lane >= o) inc += v; }
      p.small[t * 32 + 8 + h] = be; p.small[t * 32 + 12 + h] = inc;
    }
  }
}

__device__ void conv_phase(const Params& p, int layer) {
  const int tid = tidx(), lane = tid & 63, gw = bidx() * 8 + (tid >> 6), nw = (int)gridDim.x * 8;
  for (int ww = gw; ww < 512 * 5; ww += nw) {
    const int r = ww / 5, cg = ww % 5, cc = cg * 64 + lane;
    bf16_t* base; int ld; const float* cw; float bias[8];
    if (cg < 2) {
      const int ch = cc * 8; base = p.XBC + ch; ld = 1024; cw = p.ssd_conv_w + (size_t)layer * 4 * 1024 + ch;
#pragma unroll
      for (int j = 0; j < 8; ++j) bias[j] = p.ssd_conv_b[layer * 1024 + ch + j];
    } else {
      const int ch = (cc - 128) * 8; base = p.DNQKV + ch; ld = 1536; cw = p.dn_conv_w + (size_t)layer * 4 * 1536 + ch;
#pragma unroll
      for (int j = 0; j < 8; ++j) bias[j] = 0.f;
    }
    const int wld = (cg < 2) ? 1024 : 1536;
    float w[4][8];
#pragma unroll
    for (int k = 0; k < 4; ++k) {
      const f32x4 a = *(const f32x4*)(cw + k * wld), b = *(const f32x4*)(cw + k * wld + 4);
      w[k][0] = a[0]; w[k][1] = a[1]; w[k][2] = a[2]; w[k][3] = a[3]; w[k][4] = b[0]; w[k][5] = b[1]; w[k][6] = b[2]; w[k][7] = b[3];
    }
    u32x4 h0 = {0u, 0u, 0u, 0u}, h1 = h0, h2 = h0;
    if ((r & 63) != 0) {
      const bf16_t* hp = p.halo + (size_t)r * 3 * 2560 + cc * 8;
      h0 = *(const u32x4*)hp; h1 = *(const u32x4*)(hp + 2560); h2 = *(const u32x4*)(hp + 5120);
    }
    bf16_t* rowp = base + (size_t)r * 64 * ld;
    const float qs = (cg == 2) ? 0.08838834764831845f : 1.f;
    for (int i0 = 0; i0 < 64; i0 += 4) {
      u32x4 cur[4];
#pragma unroll
      for (int i = 0; i < 4; ++i) cur[i] = *(const u32x4*)(rowp + (size_t)(i0 + i) * ld);
#pragma unroll
      for (int i = 0; i < 4; ++i) {
        const u32x4 c3 = cur[i];
        float a[8];
        a[0] = bias[0] + w[0][0] * bflo(h0.x) + w[1][0] * bflo(h1.x) + w[2][0] * bflo(h2.x) + w[3][0] * bflo(c3.x);
        a[1] = bias[1] + w[0][1] * bfhi(h0.x) + w[1][1] * bfhi(h1.x) + w[2][1] * bfhi(h2.x) + w[3][1] * bfhi(c3.x);
        a[2] = bias[2] + w[0][2] * bflo(h0.y) + w[1][2] * bflo(h1.y) + w[2][2] * bflo(h2.y) + w[3][2] * bflo(c3.y);
        a[3] = bias[3] + w[0][3] * bfhi(h0.y) + w[1][3] * bfhi(h1.y) + w[2][3] * bfhi(h2.y) + w[3][3] * bfhi(c3.y);
        a[4] = bias[4] + w[0][4] * bflo(h0.z) + w[1][4] * bflo(h1.z) + w[2][4] * bflo(h2.z) + w[3][4] * bflo(c3.z);
        a[5] = bias[5] + w[0][5] * bfhi(h0.z) + w[1][5] * bfhi(h1.z) + w[2][5] * bfhi(h2.z) + w[3][5] * bfhi(c3.z);
        a[6] = bias[6] + w[0][6] * bflo(h0.w) + w[1][6] * bflo(h1.w) + w[2][6] * bflo(h2.w) + w[3][6] * bflo(c3.w);
        a[7] = bias[7] + w[0][7] * bfhi(h0.w) + w[1][7] * bfhi(h1.w) + w[2][7] * bfhi(h2.w) + w[3][7] * bfhi(c3.w);
        float ss = 0.f;
#pragma unroll
        for (int j = 0; j < 8; ++j) { a[j] = siluf_(a[j]); ss += a[j] * a[j]; }
        float rn = 1.f;
        if (cg == 2 || cg == 3) {
          ss += __shfl_xor(ss, 1); ss += __shfl_xor(ss, 2); ss += __shfl_xor(ss, 4); ss += __shfl_xor(ss, 8);
          rn = rsqrtf(ss + 1e-6f) * qs;
        }
        u32x4 o; o.x = pk_bf16(a[0] * rn, a[1] * rn); o.y = pk_bf16(a[2] * rn, a[3] * rn); o.z = pk_bf16(a[4] * rn, a[5] * rn); o.w = pk_bf16(a[6] * rn, a[7] * rn);
        *(u32x4*)(rowp + (size_t)(i0 + i) * ld) = o;
        h0 = h1; h1 = h2; h2 = c3;
      }
    }
  }
}

__device__ void sg_item(const Params& p, int layer, int item, char* lds, bool st_en) {
  const int tid = tidx(), lane = tid & 63, wave = tid >> 6;
  const int g = item & 3, t0 = (item >> 2) * 128;
  bf16_t* Vt = (bf16_t*)lds;
  bf16_t* Ws = Vt + 128 * 136;
  const float* w = p.sg_w + ((size_t)(layer * 4 + g)) * 128 * 128;
  for (int i = tid; i < 128 * 32; i += NT) {
    const int t = i >> 5, s4 = (i & 31) * 4;
    f32x4 v = *(const f32x4*)(w + t * 128 + s4);
    u32x2 o; o.x = pk_bf16(s4 + 0 <= t ? v[0] : 0.f, s4 + 1 <= t ? v[1] : 0.f); o.y = pk_bf16(s4 + 2 <= t ? v[2] : 0.f, s4 + 3 <= t ? v[3] : 0.f);
    *(u32x2*)(Ws + t * 136 + s4) = o;
  }
  const float* lg = p.sg_ln_g + layer * 512; const float* lb = p.sg_ln_b + layer * 512;
  for (int tt = 0; tt < 16; ++tt) {
    const int tok = wave * 16 + tt;
    const u32x4 raw = *(const u32x4*)(p.SGUV + (size_t)(t0 + tok) * 1024 + 512 + lane * 8);
    float x[8];
    x[0] = geluf_(bflo(raw.x)); x[1] = geluf_(bfhi(raw.x)); x[2] = geluf_(bflo(raw.y)); x[3] = geluf_(bfhi(raw.y));
    x[4] = geluf_(bflo(raw.z)); x[5] = geluf_(bfhi(raw.z)); x[6] = geluf_(bflo(raw.w)); x[7] = geluf_(bfhi(raw.w));
    float s = 0.f;
#pragma unroll
    for (int j = 0; j < 8; ++j) s += x[j];
    const float mu = wave_sum(s) * (1.f / 512.f);
    float q = 0.f;
#pragma unroll
    for (int j = 0; j < 8; ++j) { x[j] -= mu; q += x[j] * x[j]; }
    const float rstd = rsqrtf(wave_sum(q) * (1.f / 512.f) + 1e-5f);
    if ((lane >> 4) == g) {
#pragma unroll
      for (int j = 0; j < 8; ++j) {
        const int ch = lane * 8 + j, d = (lane & 15) * 8 + j;
        Vt[d * 136 + tok] = f2bf(x[j] * rstd * lg[ch] + lb[ch]);
      }
    }
  }
  __syncthreads();
  const int K = ((wave * 16 + 15) / 32 + 1) * 32;
  const int tok = wave * 16 + (lane & 15);
  const float bias = p.sg_b[(size_t)(layer * 4 + g) * 128 + tok];
#pragma unroll
  for (int nt = 0; nt < 8; ++nt) {
    f32x4 acc = {0.f, 0.f, 0.f, 0.f};
    acc = mma16(Vt + nt * 16 * 136, 136, Ws + wave * 16 * 136, 136, K, acc, lane);
    const int ch = g * 128 + nt * 16 + (lane >> 4) * 4;
    bf16_t* up = p.SGUV + (size_t)(t0 + tok) * 1024 + ch;
    const u32x2 ur = *(const u32x2*)up;
    u32x2 o;
    o.x = pk_bf16(geluf_(bflo(ur.x)) * (acc[0] + bias), geluf_(bfhi(ur.x)) * (acc[1] + bias));
    o.y = pk_bf16(geluf_(bflo(ur.y)) * (acc[2] + bias), geluf_(bfhi(ur.y)) * (acc[3] + bias));
    if (st_en) *(u32x2*)up = o;
  }
  __syncthreads();
}

__device__ void fox_item(const Params& p, int layer, int item, char* lds, bool st_en) {
  const int tid = tidx(), lane = tid & 63, wave = tid >> 6;
  const int qb = item & 31, bh = item >> 5, b = bh >> 3, h = bh & 7;
  bf16_t* Ks = (bf16_t*)lds;
  bf16_t* Vt = Ks + 64 * 72;
  float* ck = (float*)(Vt + 64 * 72);
  const float LOG2E = 1.4426950408889634f;
  const float sl2 = 0.125f * LOG2E;
  const bf16_t* base = p.FOXQKV + (size_t)b * SEQL * 1536;
  const float* cb = p.cbuf + (size_t)bh * SEQL;
  const int q0 = qb * 128 + wave * 16;
  const int qi = q0 + (lane & 15);
  bf16x8 qf[2];
  qf[0] = *(const bf16x8*)(base + (size_t)qi * 1536 + h * 64 + (lane >> 4) * 8);
  qf[1] = *(const bf16x8*)(base + (size_t)qi * 1536 + h * 64 + 32 + (lane >> 4) * 8);
  const float cq = cb[qi] * LOG2E;
  f32x4 o[4];
#pragma unroll
  for (int i = 0; i < 4; ++i) o[i] = (f32x4){0.f, 0.f, 0.f, 0.f};
  float mrun = -INFINITY, lrun = 0.f;
  const int ntiles = (qb + 1) * 2;
  int jstart;
  {
    float* red = (float*)lds;
    float qs = 0.f;
#pragma unroll
    for (int i = 0; i < 2; ++i) {
      u32x4 w; __builtin_memcpy(&w, &qf[i], 16);
      qs += bflo(w.x) * bflo(w.x) + bfhi(w.x) * bfhi(w.x) + bflo(w.y) * bflo(w.y) + bfhi(w.y) * bfhi(w.y)
          + bflo(w.z) * bflo(w.z) + bfhi(w.z) * bfhi(w.z) + bflo(w.w) * bflo(w.w) + bfhi(w.w) * bfhi(w.w);
    }
    qs += __shfl_xor(qs, 16); qs += __shfl_xor(qs, 32);
#pragma unroll
    for (int o = 8; o >= 1; o >>= 1) qs = fmaxf(qs, __shfl_xor(qs, o));
    if (lane == 0) red[wave] = qs;
    __syncthreads();
    float qm = red[0];
#pragma unroll
    for (int w = 1; w < 8; ++w) qm = fmaxf(qm, red[w]);
    const float qkmax = sqrtf(qm) * ((const float*)(p.ctrl + 64))[bh] * sl2;
    const float thr = -152.f - 2.f * qkmax;
    const float cfirst = cb[qb * 128] * LOG2E;
    const bool live = (lane < ntiles) && (cfirst - cb[lane * 64 + 63] * LOG2E >= thr);
    const unsigned long long bal = __ballot(live);
    jstart = bal ? (int)__builtin_ctzll(bal) : 0;
    __syncthreads();
  }
  const int lkey = tid >> 3, lseg = (tid & 7) * 8;
  u32x4 kr = *(const u32x4*)(base + (size_t)(jstart * 64 + lkey) * 1536 + 512 + h * 64 + lseg);
  u32x4 vr = *(const u32x4*)(base + (size_t)(jstart * 64 + lkey) * 1536 + 1024 + h * 64 + lseg);
  float ckv = (tid < 64) ? cb[jstart * 64 + tid] * LOG2E : 0.f;
  for (int j = jstart; j < ntiles; ++j) {
    const int k0 = j * 64;
    __syncthreads();
    *(u32x4*)(Ks + lkey * 72 + lseg) = kr;
    Vt[(lseg + 0) * 72 + lkey] = (bf16_t)(vr.x & 0xffff); Vt[(lseg + 1) * 72 + lkey] = (bf16_t)(vr.x >> 16);
    Vt[(lseg + 2) * 72 + lkey] = (bf16_t)(vr.y & 0xffff); Vt[(lseg + 3) * 72 + lkey] = (bf16_t)(vr.y >> 16);
    Vt[(lseg + 4) * 72 + lkey] = (bf16_t)(vr.z & 0xffff); Vt[(lseg + 5) * 72 + lkey] = (bf16_t)(vr.z >> 16);
    Vt[(lseg + 6) * 72 + lkey] = (bf16_t)(vr.w & 0xffff); Vt[(lseg + 7) * 72 + lkey] = (bf16_t)(vr.w >> 16);
    if (tid < 64) ck[tid] = ckv;
    if (j + 1 < ntiles) {
      kr = *(const u32x4*)(base + (size_t)(k0 + 64 + lkey) * 1536 + 512 + h * 64 + lseg);
      vr = *(const u32x4*)(base + (size_t)(k0 + 64 + lkey) * 1536 + 1024 + h * 64 + lseg);
      if (tid < 64) ckv = cb[k0 + 64 + tid] * LOG2E;
    }
    __syncthreads();
    if (k0 > q0 + 15) continue;
    f32x4 s[4];
#pragma unroll
    for (int kt = 0; kt < 4; ++kt) {
      const bf16_t* ka = Ks + (kt * 16 + (lane & 15)) * 72 + (lane >> 4) * 8;
      f32x4 a = {0.f, 0.f, 0.f, 0.f};
      a = __builtin_amdgcn_mfma_f32_16x16x32_bf16(*(const bf16x8*)ka, qf[0], a, 0, 0, 0);
      a = __builtin_amdgcn_mfma_f32_16x16x32_bf16(*(const bf16x8*)(ka + 32), qf[1], a, 0, 0, 0);
      s[kt] = a;
    }
    const bool diag = (k0 + 63 > q0);
    float mx = -INFINITY;
#pragma unroll
    for (int kt = 0; kt < 4; ++kt) {
      const f32x4 c4 = *(const f32x4*)(ck + kt * 16 + (lane >> 4) * 4);
#pragma unroll
      for (int r = 0; r < 4; ++r) {
        float v = s[kt][r] * sl2 + (cq - c4[r]);
        if (diag && (k0 + kt * 16 + (lane >> 4) * 4 + r > qi)) v = -INFINITY;
        s[kt][r] = v; mx = fmaxf(mx, v);
      }
    }
    mx = fmaxf(mx, __shfl_xor(mx, 16)); mx = fmaxf(mx, __shfl_xor(mx, 32));
    const float mnew = fmaxf(mrun, mx);
    const float alpha = __builtin_amdgcn_exp2f(mrun - mnew);
    mrun = mnew;
    float ps = 0.f;
#pragma unroll
    for (int kt = 0; kt < 4; ++kt)
#pragma unroll
      for (int r = 0; r < 4; ++r) { const float pv = __builtin_amdgcn_exp2f(s[kt][r] - mnew); s[kt][r] = pv; ps += pv; }
    lrun = lrun * alpha + ps;
#pragma unroll
    for (int i = 0; i < 4; ++i) o[i] = o[i] * alpha;
#pragma unroll
    for (int t2 = 0; t2 < 2; ++t2) {
      u32x4 pw; pw.x = pk_bf16(s[2 * t2][0], s[2 * t2][1]); pw.y = pk_bf16(s[2 * t2][2], s[2 * t2][3]);
      pw.z = pk_bf16(s[2 * t2 + 1][0], s[2 * t2 + 1][1]); pw.w = pk_bf16(s[2 * t2 + 1][2], s[2 * t2 + 1][3]);
      bf16x8 pf; __builtin_memcpy(&pf, &pw, 16);
#pragma unroll
      for (int dt = 0; dt < 4; ++dt) {
        const bf16_t* va = Vt + (dt * 16 + (lane & 15)) * 72 + t2 * 32 + (lane >> 4) * 4;
        u32x2 v0 = *(const u32x2*)va, v1 = *(const u32x2*)(va + 16);
        u32x4 vw; vw.x = v0.x; vw.y = v0.y; vw.z = v1.x; vw.w = v1.y;
        bf16x8 vf; __builtin_memcpy(&vf, &vw, 16);
        o[dt] = __builtin_amdgcn_mfma_f32_16x16x32_bf16(vf, pf, o[dt], 0, 0, 0);
      }
    }
  }
  lrun += __shfl_xor(lrun, 16); lrun += __shfl_xor(lrun, 32);
  const float inv = 1.f / lrun;
  bf16_t* op = p.FOXQKV + (size_t)(b * SEQL + qi) * 1536 + h * 64 + (lane >> 4) * 4;
#pragma unroll
  for (int dt = 0; dt < 4; ++dt) {
    u32x2 w; w.x = pk_bf16(o[dt][0] * inv, o[dt][1] * inv); w.y = pk_bf16(o[dt][2] * inv, o[dt][3] * inv);
    if (st_en) *(u32x2*)(op + dt * 16) = w;
  }
  __syncthreads();
}

__device__ void ssd_item(const Params& p, int layer, int item, char* lds, bool st_en) {
  const int tid = tidx(), lane = tid & 63, wave = tid >> 6;
  const int b = item >> 3, h = item & 7, g = h >> 2;
  bf16_t* Cs = (bf16_t*)(lds + opq(0));
  bf16_t* Bs = (bf16_t*)(lds + opq(17408));
  bf16_t* XT = (bf16_t*)(lds + opq(34816));
  bf16_t* XdT = (bf16_t*)(lds + opq(44032));
  bf16_t* Xr = (bf16_t*)(lds + opq(53248));
  bf16_t* CBm = (bf16_t*)(lds + opq(62464));
  bf16_t* Pb = (bf16_t*)(lds + opq(71680));
  float* acs = (float*)(lds + opq(89088));
  float* dtv = acs + 64;
  float* part = dtv + 64;
  const float* cw = p.ssd_conv_w + (size_t)layer * 4 * 1024;
  const float* cbias = p.ssd_conv_b + (size_t)layer * 1024;
  const float dtb = p.ssd_dt_bias[layer * 8 + h], aneg = -__expf(p.ssd_a_log[layer * 8 + h]), dsk = p.ssd_d[layer * 8 + h];
  const float* nw = p.ssd_norm_w + layer * 512 + h * 64;
  const int lt = wave >> 1, pt0 = (wave & 1) * 2;
  f32x4 st[4];
#pragma unroll
  for (int i = 0; i < 4; ++i) st[i] = (f32x4){0.f, 0.f, 0.f, 0.f};
  for (int i = tid; i < 64 * 136; i += NT) Pb[i] = 0;
  u32x4 xc, bc[2], ccv[2]; u32x2 zpre[2]; float apre = 0.f, dpre = 0.f;
  auto prefetch = [&](int step) {
    const size_t tbn = (size_t)b * SEQL + step * 64;
    const bf16_t* rp = p.XBC + tbn * 1024;
    xc = *(const u32x4*)(rp + (size_t)(tid >> 3) * 1024 + h * 64 + (tid & 7) * 8);
#pragma unroll
    for (int c = 0; c < 2; ++c) {
      const int id = tid + c * 512, s = id >> 4, col = (id & 15) * 8;
      bc[c] = *(const u32x4*)(rp + (size_t)s * 1024 + 512 + g * 128 + col);
      ccv[c] = *(const u32x4*)(rp + (size_t)s * 1024 + 768 + g * 128 + col);
    }
#pragma unroll
    for (int i = 0; i < 2; ++i)
      zpre[i] = *(const u32x2*)(p.Z + (tbn + lt * 16 + (lane & 15)) * 512 + h * 64 + (pt0 + i) * 16 + (lane >> 4) * 4);
    if (tid < 64) { apre = p.small[(tbn + tid) * 32 + 24 + h]; dpre = p.small[(tbn + tid) * 32 + h]; }
  };
  prefetch(0);
  for (int step = 0; step < 64; ++step) {
    const int l0 = step * 64;
    const size_t tb = (size_t)b * SEQL + l0;
    __syncthreads();
    if (wave == 0) { acs[lane] = apre; dtv[lane] = dpre; }
    const u32x4 xc_c = xc, bc0 = bc[0], bc1 = bc[1], cc0 = ccv[0], cc1 = ccv[1];
    const u32x2 zc0 = zpre[0], zc1 = zpre[1];
    if (step + 1 < 64) prefetch(step + 1);
    __syncthreads();
    {
      const float alast = acs[63];
      const int s = tid >> 3, col = (tid & 7) * 8;
      const float dt = dtv[s], dec = __expf(alast - acs[s]);
      *(u32x4*)(Xr + s * 72 + col) = xc_c;
      float a[8] = {bflo(xc_c.x), bfhi(xc_c.x), bflo(xc_c.y), bfhi(xc_c.y), bflo(xc_c.z), bfhi(xc_c.z), bflo(xc_c.w), bfhi(xc_c.w)};
#pragma unroll
      for (int j = 0; j < 8; ++j) { const float xd = a[j] * dt; XT[(col + j) * 72 + s] = f2bf(xd); XdT[(col + j) * 72 + s] = f2bf(xd * dec); }
#pragma unroll
      for (int c = 0; c < 2; ++c) {
        const int id = tid + c * 512, s2 = id >> 4, col2 = (id & 15) * 8;
        *(u32x4*)(Bs + s2 * 136 + col2) = c ? bc1 : bc0;
        *(u32x4*)(Cs + s2 * 136 + col2) = c ? cc1 : cc0;
      }
    }
    __syncthreads();
#pragma unroll
    for (int i = 0; i < 2; ++i) {
      const int id = wave * 2 + i, lt2 = id >> 2, st2 = id & 3;
      f32x4 a = {0.f, 0.f, 0.f, 0.f};
      a = mma16(Bs + st2 * 16 * 136, 136, Cs + lt2 * 16 * 136, 136, 128, a, lane);
      const int l = lt2 * 16 + (lane & 15), s0 = st2 * 16 + (lane >> 4) * 4;
      const float al = acs[l];
      float v[4];
#pragma unroll
      for (int r = 0; r < 4; ++r) v[r] = (s0 + r <= l) ? a[r] * __expf(al - acs[s0 + r]) : 0.f;
      u32x2 w; w.x = pk_bf16(v[0], v[1]); w.y = pk_bf16(v[2], v[3]);
      *(u32x2*)(CBm + l * 72 + s0) = w;
    }
    f32x4 yo[2];
#pragma unroll
    for (int i = 0; i < 2; ++i) {
      f32x4 a = {0.f, 0.f, 0.f, 0.f};
      yo[i] = mma16(Pb + (pt0 + i) * 16 * 136, 136, Cs + lt * 16 * 136, 136, 128, a, lane);
    }
    __syncthreads();
    {
      const int l = lt * 16 + (lane & 15);
      const float el = __expf(acs[l]);
      const size_t tok = tb + l;
      float ssq = 0.f;
#pragma unroll
      for (int i = 0; i < 2; ++i) {
        f32x4 a = {0.f, 0.f, 0.f, 0.f};
        a = mma16(XT + (pt0 + i) * 16 * 72, 72, CBm + lt * 16 * 72, 72, 64, a, lane);
        const int pp = (pt0 + i) * 16 + (lane >> 4) * 4;
        const u32x2 xr = *(const u32x2*)(Xr + l * 72 + pp);
        bf16_t* zp = p.Z + tok * 512 + h * 64 + pp;
        const u32x2 zr = i ? zc1 : zc0;
        const f32x4 nv = *(const f32x4*)(nw + pp);
        float y[4];
        y[0] = (a[0] + yo[i][0] * el + dsk * bflo(xr.x)) * siluf_(bflo(zr.x));
        y[1] = (a[1] + yo[i][1] * el + dsk * bfhi(xr.x)) * siluf_(bfhi(zr.x));
        y[2] = (a[2] + yo[i][2] * el + dsk * bflo(xr.y)) * siluf_(bflo(zr.y));
        y[3] = (a[3] + yo[i][3] * el + dsk * bfhi(xr.y)) * siluf_(bfhi(zr.y));
        ssq += (y[0] * y[0] + y[1] * y[1]) + (y[2] * y[2] + y[3] * y[3]);
        u32x2 w; w.x = pk_bf16(y[0] * nv[0], y[1] * nv[1]); w.y = pk_bf16(y[2] * nv[2], y[3] * nv[3]);
        if (st_en) *(u32x2*)zp = w;
      }
      ssq += __shfl_xor(ssq, 16); ssq += __shfl_xor(ssq, 32);
      if (lane < 16) part[(wave & 1) * 64 + l] = ssq;
    }
    {
      const float ea = __expf(acs[63]);
      const int n = wave * 16 + (lane & 15);
      bf16x8 bfr[2];
#pragma unroll
      for (int ks = 0; ks < 2; ++ks) {
        u32x4 w;
        const bf16_t* bp = Bs + (ks * 32 + (lane >> 4) * 8) * 136 + n;
        w.x = (unsigned)bp[0] | ((unsigned)bp[136] << 16); w.y = (unsigned)bp[2 * 136] | ((unsigned)bp[3 * 136] << 16);
        w.z = (unsigned)bp[4 * 136] | ((unsigned)bp[5 * 136] << 16); w.w = (unsigned)bp[6 * 136] | ((unsigned)bp[7 * 136] << 16);
        __builtin_memcpy(&bfr[ks], &w, 16);
      }
#pragma unroll
      for (int i = 0; i < 4; ++i) {
        f32x4 a = st[i] * ea;
        const bf16_t* ap = XdT + (i * 16 + (lane & 15)) * 72 + (lane >> 4) * 8;
        a = __builtin_amdgcn_mfma_f32_16x16x32_bf16(*(const bf16x8*)ap, bfr[0], a, 0, 0, 0);
        a = __builtin_amdgcn_mfma_f32_16x16x32_bf16(*(const bf16x8*)(ap + 32), bfr[1], a, 0, 0, 0);
        st[i] = a;
#pragma unroll
        for (int r = 0; r < 4; ++r) Pb[(i * 16 + (lane >> 4) * 4 + r) * 136 + n] = f2bf(a[r]);
      }
    }
    __syncthreads();
    if (tid < 64 && st_en) p.ssqp[(size_t)h * MTOK + tb + tid] = part[tid] + part[64 + tid];
  }
  __syncthreads();
}

__device__ __forceinline__ bf16_t* dn_Wg(const Params& p) { return (bf16_t*)p.hf; }
__device__ __forceinline__ float* dn_Ug(const Params& p) { return (float*)((char*)p.hf + ((size_t)32 << 20)); }
__device__ __forceinline__ bf16_t* dn_QKg(const Params& p) { return (bf16_t*)((char*)p.hf + ((size_t)96 << 20)); }

__device__ void dn_prep_item(const Params& p, int layer, int item, char* lds) {
  const int tid = tidx(), lane = tid & 63, wave = tid >> 6;
  const int step = item & 63, bh = item >> 6, b = bh >> 2, h = bh & 3;
  bf16_t* Kn = (bf16_t*)(lds + opq(0));
  bf16_t* Qn = (bf16_t*)(lds + opq(17408));
  bf16_t* Wm = (bf16_t*)(lds + opq(34816));
  bf16_t* QK = (bf16_t*)(lds + opq(52224));
  float* At = (float*)(lds + opq(61440));
  float* VU = (float*)(lds + opq(79872));
  float* gcs = (float*)(lds + opq(148480));
  float* bet = gcs + 64;
  const size_t tb = (size_t)b * SEQL + step * 64;
  __syncthreads();
  if (wave == 0) { gcs[lane] = p.small[(tb + lane) * 32 + 12 + h]; bet[lane] = p.small[(tb + lane) * 32 + 8 + h]; }
  u32x4 qv[2], kv[2], vv[2];
  {
    const bf16_t* rp = p.DNQKV + tb * 1536 + h * 128;
#pragma unroll
    for (int c = 0; c < 2; ++c) {
      const int id = tid + c * 512, s = id >> 4, dd = (id & 15) * 8;
      qv[c] = *(const u32x4*)(rp + (size_t)s * 1536 + dd);
      kv[c] = *(const u32x4*)(rp + (size_t)s * 1536 + 512 + dd);
      vv[c] = *(const u32x4*)(rp + (size_t)s * 1536 + 1024 + dd);
    }
  }
  __syncthreads();
#pragma unroll
  for (int c = 0; c < 2; ++c) {
    const int id = tid + c * 512, s = id >> 4, dd = (id & 15) * 8;
    *(u32x4*)(Qn + s * 136 + dd) = qv[c];
    *(u32x4*)(Kn + s * 136 + dd) = kv[c];
    const float be = bet[s];
    f32x4 v0 = {bflo(vv[c].x) * be, bfhi(vv[c].x) * be, bflo(vv[c].y) * be, bfhi(vv[c].y) * be};
    f32x4 v1 = {bflo(vv[c].z) * be, bfhi(vv[c].z) * be, bflo(vv[c].w) * be, bfhi(vv[c].w) * be};
    *(f32x4*)(VU + s * 132 + dd) = v0; *(f32x4*)(VU + s * 132 + dd + 4) = v1;
  }
  __syncthreads();
#pragma unroll
  for (int t = 0; t < 2; ++t) {
    const int id = wave * 2 + t, it = id >> 2, jt = id & 3;
    const int i = it * 16 + (lane & 15), j0 = jt * 16 + (lane >> 4) * 4;
    const float gi = gcs[i], bi = bet[i];
    f32x4 a = {0.f, 0.f, 0.f, 0.f};
    a = mma16(Kn + jt * 16 * 136, 136, Kn + it * 16 * 136, 136, 128, a, lane);
#pragma unroll
    for (int r = 0; r < 4; ++r) At[(j0 + r) * 64 + i] = (j0 + r < i) ? bi * a[r] * __expf(gi - gcs[j0 + r]) : 0.f;
    f32x4 q = {0.f, 0.f, 0.f, 0.f};
    q = mma16(Kn + jt * 16 * 136, 136, Qn + it * 16 * 136, 136, 128, q, lane);
    float qq[4];
#pragma unroll
    for (int r = 0; r < 4; ++r) qq[r] = (j0 + r <= i) ? q[r] * __expf(gi - gcs[j0 + r]) : 0.f;
    u32x2 w; w.x = pk_bf16(qq[0], qq[1]); w.y = pk_bf16(qq[2], qq[3]);
    *(u32x2*)(QK + i * 72 + j0) = w;
  }
  __syncthreads();
  if (tid < 256) {
    float xs[64];
    if (tid < 128) {
#pragma unroll
      for (int s = 0; s < 64; ++s) xs[s] = bf2f(Kn[s * 136 + tid]) * bet[s] * __expf(gcs[s]);
    } else {
#pragma unroll
      for (int s = 0; s < 64; ++s) xs[s] = VU[s * 132 + (tid - 128)];
    }
#pragma unroll
    for (int j = 0; j < 63; ++j) {
      const float xj = xs[j];
#pragma unroll
      for (int i = j + 1; i < 64; ++i) xs[i] -= At[j * 64 + i] * xj;
      if ((j & 3) == 3) asm volatile("" ::: "memory");
    }
    if (tid < 128) {
#pragma unroll
      for (int s = 0; s < 64; ++s) Wm[s * 136 + tid] = f2bf(xs[s]);
    } else {
#pragma unroll
      for (int s = 0; s < 64; ++s) VU[s * 132 + (tid - 128)] = xs[s];
    }
  }
  __syncthreads();
  {
    bf16_t* Wg = dn_Wg(p) + tb * 512 + h * 128;
    float* Ug = dn_Ug(p) + tb * 512 + h * 128;
    bf16_t* QKg = dn_QKg(p) + ((tb >> 6) * 4 + h) * 4096;
#pragma unroll
    for (int c = 0; c < 2; ++c) {
      const int id = tid + c * 512, s = id >> 4, dd = (id & 15) * 8;
      *(u32x4*)(Wg + (size_t)s * 512 + dd) = *(const u32x4*)(Wm + s * 136 + dd);
    }
#pragma unroll
    for (int c = 0; c < 4; ++c) {
      const int id = tid + c * 512, s = id >> 5, e4 = (id & 31) * 4;
      *(f32x4*)(Ug + (size_t)s * 512 + e4) = *(const f32x4*)(VU + s * 132 + e4);
    }
    *(u32x4*)(QKg + (tid >> 3) * 64 + (tid & 7) * 8) = *(const u32x4*)(QK + (tid >> 3) * 72 + (tid & 7) * 8);
  }
}

__device__ void dn_scan_item(const Params& p, int layer, int item, char* lds, bool st_en) {
  const int tid = tidx(), lane = tid & 63, wave = tid >> 6;
  const int b = item >> 2, h = item & 3;
  bf16_t* Kn = (bf16_t*)(lds + opq(0));
  bf16_t* Qn = (bf16_t*)(lds + opq(17408));
  bf16_t* Wm = (bf16_t*)(lds + opq(34816));
  bf16_t* QK = (bf16_t*)(lds + opq(52224));
  bf16_t* VnT = (bf16_t*)(lds + opq(61440));
  float* VU = (float*)(lds + opq(79872));
  bf16_t* ST = (bf16_t*)(lds + opq(113664));
  float* gcs = (float*)(lds + opq(148480));
  float* Of = (float*)Qn;
  const float* nw = p.dn_norm_w + layer * 128;
  f32x4 S[8];
#pragma unroll
  for (int i = 0; i < 8; ++i) S[i] = (f32x4){0.f, 0.f, 0.f, 0.f};
  for (int i = tid; i < 128 * 136; i += NT) ST[i] = 0;
  u32x4 wv[2], qv[2], kv[2], qkv; f32x4 uv[4]; float gv = 0.f; unsigned gpre[8];
  auto prefetch = [&](int step) {
    const size_t tb = (size_t)b * SEQL + step * 64;
    const bf16_t* rp = p.DNQKV + tb * 1536 + h * 128;
    const bf16_t* Wg = dn_Wg(p) + tb * 512 + h * 128;
    const float* Ug = dn_Ug(p) + tb * 512 + h * 128;
    const bf16_t* QKg = dn_QKg(p) + ((tb >> 6) * 4 + h) * 4096;
#pragma unroll
    for (int c = 0; c < 2; ++c) {
      const int id = tid + c * 512, s = id >> 4, dd = (id & 15) * 8;
      qv[c] = *(const u32x4*)(rp + (size_t)s * 1536 + dd);
      kv[c] = *(const u32x4*)(rp + (size_t)s * 1536 + 512 + dd);
      wv[c] = *(const u32x4*)(Wg + (size_t)s * 512 + dd);
    }
#pragma unroll
    for (int c = 0; c < 4; ++c) {
      const int id = tid + c * 512, s = id >> 5, e4 = (id & 31) * 4;
      uv[c] = *(const f32x4*)(Ug + (size_t)s * 512 + e4);
    }
    qkv = *(const u32x4*)(QKg + (tid >> 3) * 64 + (tid & 7) * 8);
    if (tid < 64) gv = p.small[(tb + tid) * 32 + 12 + h];
#pragma unroll
    for (int tt = 0; tt < 8; ++tt) gpre[tt] = *(const unsigned*)(p.DNG + (tb + wave * 8 + tt) * 512 + h * 128 + lane * 2);
  };
  prefetch(0);
  for (int step = 0; step < 64; ++step) {
    const size_t tb = (size_t)b * SEQL + step * 64;
    __syncthreads();
#pragma unroll
    for (int c = 0; c < 2; ++c) {
      const int id = tid + c * 512, s = id >> 4, dd = (id & 15) * 8;
      *(u32x4*)(Qn + s * 136 + dd) = qv[c];
      *(u32x4*)(Kn + s * 136 + dd) = kv[c];
      *(u32x4*)(Wm + s * 136 + dd) = wv[c];
    }
#pragma unroll
    for (int c = 0; c < 4; ++c) {
      const int id = tid + c * 512, s = id >> 5, e4 = (id & 31) * 4;
      *(f32x4*)(VU + s * 132 + e4) = uv[c];
    }
    *(u32x4*)(QK + (tid >> 3) * 72 + (tid & 7) * 8) = qkv;
    if (tid < 64) gcs[tid] = gv;
    unsigned gcur[8];
#pragma unroll
    for (int tt = 0; tt < 8; ++tt) gcur[tt] = gpre[tt];
    if (step + 1 < 64) prefetch(step + 1);
    __syncthreads();
    f32x4 o1[4];
    {
      const int stl = wave >> 1;
#pragma unroll
      for (int i = 0; i < 4; ++i) {
        const int et = (wave & 1) * 4 + i;
        f32x4 a = {0.f, 0.f, 0.f, 0.f};
        a = mma16(Wm + stl * 16 * 136, 136, ST + et * 16 * 136, 136, 128, a, lane);
        const int s0 = stl * 16 + (lane >> 4) * 4, e = et * 16 + (lane & 15);
        float vn[4];
#pragma unroll
        for (int r = 0; r < 4; ++r) vn[r] = VU[(s0 + r) * 132 + e] - a[r];
        u32x2 w; w.x = pk_bf16(vn[0], vn[1]); w.y = pk_bf16(vn[2], vn[3]);
        *(u32x2*)(VnT + e * 72 + s0) = w;
        f32x4 q = {0.f, 0.f, 0.f, 0.f};
        q = mma16(ST + et * 16 * 136, 136, Qn + stl * 16 * 136, 136, 128, q, lane);
        const float eg = __expf(gcs[stl * 16 + (lane & 15)]);
        o1[i] = q * eg;
      }
    }
    __syncthreads();
    {
      const int stl = wave >> 1;
#pragma unroll
      for (int i = 0; i < 4; ++i) {
        const int et = (wave & 1) * 4 + i;
        f32x4 a = mma16(VnT + et * 16 * 72, 72, QK + stl * 16 * 72, 72, 64, o1[i], lane);
        const int s = stl * 16 + (lane & 15), e0 = et * 16 + (lane >> 4) * 4;
        *(f32x4*)(Of + s * 132 + e0) = a;
      }
      const float gl = gcs[63], egl = __expf(gl);
      bf16x8 kf[2];
#pragma unroll
      for (int ks = 0; ks < 2; ++ks) {
        const int d = wave * 16 + (lane & 15), s0 = ks * 32 + (lane >> 4) * 8;
        float kk[8];
#pragma unroll
        for (int j = 0; j < 8; ++j) kk[j] = bf2f(Kn[(s0 + j) * 136 + d]) * __expf(gl - gcs[s0 + j]);
        u32x4 w; w.x = pk_bf16(kk[0], kk[1]); w.y = pk_bf16(kk[2], kk[3]); w.z = pk_bf16(kk[4], kk[5]); w.w = pk_bf16(kk[6], kk[7]);
        __builtin_memcpy(&kf[ks], &w, 16);
      }
#pragma unroll
      for (int et = 0; et < 8; ++et) {
        f32x4 a = S[et] * egl;
        const bf16_t* vp = VnT + (et * 16 + (lane & 15)) * 72 + (lane >> 4) * 8;
        a = __builtin_amdgcn_mfma_f32_16x16x32_bf16(kf[0], *(const bf16x8*)vp, a, 0, 0, 0);
        a = __builtin_amdgcn_mfma_f32_16x16x32_bf16(kf[1], *(const bf16x8*)(vp + 32), a, 0, 0, 0);
        S[et] = a;
      }
    }
    __syncthreads();
#pragma unroll
    for (int et = 0; et < 8; ++et) {
      u32x2 w; w.x = pk_bf16(S[et][0], S[et][1]); w.y = pk_bf16(S[et][2], S[et][3]);
      *(u32x2*)(ST + (et * 16 + (lane & 15)) * 136 + wave * 16 + (lane >> 4) * 4) = w;
    }
#pragma unroll
    for (int tt = 0; tt < 8; ++tt) {
      const int s = wave * 8 + tt;
      const float o0 = Of[s * 132 + lane * 2], o1v = Of[s * 132 + lane * 2 + 1];
      const float ss = wave_sum(o0 * o0 + o1v * o1v);
      const float rn = rsqrtf(ss * (1.f / 128.f) + 1e-6f);
      const unsigned gr = gcur[tt];
      const float y0 = o0 * rn * nw[lane * 2] * siluf_(bflo(gr)), y1 = o1v * rn * nw[lane * 2 + 1] * siluf_(bfhi(gr));
      if (st_en) *(unsigned*)(p.DNG + (tb + s) * 512 + h * 128 + lane * 2) = pk_bf16(y0, y1);
    }
  }
  __syncthreads();
}

__device__ void mixer_phase1(const Params& p, int layer, char* lds) {
  for (int it = bidx(); it < 2048; it += (int)gridDim.x) dn_prep_item(p, layer, it, lds);
  __syncthreads();
}
__device__ void mixer_phase2(const Params& p, int layer, char* lds, int* s_item) {
  constexpr int N_SEQ = 96, N_FOX = 2048, N_SG = 1024, TOTAL = N_SEQ + N_FOX + N_SG;
  unsigned* ctr = p.ctrl + layer;
  for (;;) {
    if (tidx() == 0) *s_item = (int)atomicAdd(ctr, 1u);
    __syncthreads();
    const int it = *s_item;
    __syncthreads();
    if (it >= TOTAL) break;
    if (it < 32) dn_scan_item(p, layer, it, lds, true);
    else if (it < N_SEQ) ssd_item(p, layer, it - 32, lds, true);
    else if (it < N_SEQ + N_FOX) { const int u = it - N_SEQ; fox_item(p, layer, ((u & 63) << 5) | (31 - (u >> 6)), lds, true); }
    else sg_item(p, layer, it - N_SEQ - N_FOX, lds, true);
  }
}

__device__ void merge_phase(const Params& p, int layer, PG8_LAS unsigned char* lds3) {
  const int lane = tidx() & 63, wave = tidx() >> 6, wm = wave >> 2, wn = wave & 3;
  bf16_t* merged = p.XBC;
  for (int t = bidx(); t < 256 * 8; t += gridDim.x) {
    const int mt = t >> 3, nt = t & 7, m0 = mt * 128, n0 = nt * 128;
    f32x16 mg[2][1];
    zero_acc<2, 1>(mg);
    float rs[2];
#pragma unroll
    for (int mi = 0; mi < 2; ++mi) {
      const int m = m0 + wm * 64 + mi * 32 + (lane & 31);
      float ss = 0.f;
#pragma unroll
      for (int hh = 0; hh < 8; ++hh) ss += p.ssqp[(size_t)hh * MTOK + m];
      rs[mi] = rsqrtf(ss * (1.f / 512.f) + 1e-6f);
    }
#pragma unroll 1
    for (int br = 0; br < 4; ++br) {
      unsigned gp[2][8];
      {
        f32x16 acc[2][1];
        zero_acc<2, 1>(acc);
        gemm_mainloop_dma128<2, 1>(p.hb + (size_t)m0 * DM, DM, p.WinT + (size_t)(NPROJ + br * 1024 + n0) * DM, DM, DM, lds3, acc);
        const float* gb = p.gate_b + (size_t)(layer * 4 + br) * 1024 + n0;
#pragma unroll
        for (int mi = 0; mi < 2; ++mi)
#pragma unroll
          for (int q = 0; q < 4; ++q) {
            const f32x4 bv = *(const f32x4*)(gb + wn * 32 + q * 8 + (lane >> 5) * 4);
            gp[mi][q * 2 + 0] = pk_bf16(sigmoidf_(acc[mi][0][q * 4 + 0] + bv[0]), sigmoidf_(acc[mi][0][q * 4 + 1] + bv[1]));
            gp[mi][q * 2 + 1] = pk_bf16(sigmoidf_(acc[mi][0][q * 4 + 2] + bv[2]), sigmoidf_(acc[mi][0][q * 4 + 3] + bv[3]));
          }
      }
      const bf16_t* ya; int lda;
      if (br == 0) { ya = p.Z; lda = 512; }
      else if (br == 1) { ya = p.DNG; lda = 512; }
      else if (br == 2) { ya = p.SGUV; lda = 1024; }
      else { ya = p.FOXQKV; lda = 1536; }
      f32x16 acc[2][1];
      zero_acc<2, 1>(acc);
      gemm_mainloop_dma128<2, 1>(ya + (size_t)m0 * lda, lda, p.WbT + ((size_t)br * 1024 + n0) * 512, 512, 512, lds3, acc);
#pragma unroll
      for (int mi = 0; mi < 2; ++mi) {
        const float sc = (br == 0) ? rs[mi] : 1.f;
#pragma unroll
        for (int q = 0; q < 4; ++q) {
          mg[mi][0][q * 4 + 0] += bflo(gp[mi][q * 2 + 0]) * acc[mi][0][q * 4 + 0] * sc;
          mg[mi][0][q * 4 + 1] += bfhi(gp[mi][q * 2 + 0]) * acc[mi][0][q * 4 + 1] * sc;
          mg[mi][0][q * 4 + 2] += bflo(gp[mi][q * 2 + 1]) * acc[mi][0][q * 4 + 2] * sc;
          mg[mi][0][q * 4 + 3] += bfhi(gp[mi][q * 2 + 1]) * acc[mi][0][q * 4 + 3] * sc;
        }
      }
    }
#pragma unroll
    for (int mi = 0; mi < 2; ++mi) {
      const int m = m0 + wm * 64 + mi * 32 + (lane & 31);
#pragma unroll
      for (int q = 0; q < 4; ++q) {
        const int n = n0 + wn * 32 + q * 8 + (lane >> 5) * 4;
        u32x2 w; w.x = pk_bf16(mg[mi][0][q * 4 + 0], mg[mi][0][q * 4 + 1]); w.y = pk_bf16(mg[mi][0][q * 4 + 2], mg[mi][0][q * 4 + 3]);
        *(u32x2*)(merged + (size_t)m * DM + n) = w;
      }
    }
  }
}

__device__ void resid_gemm_phase(const Params& p, const bf16_t* A, int K, const bf16_t* Bt, char* lds) {
  const int lane = tidx() & 63, wave = tidx() >> 6, wm = wave >> 2, wn = wave & 3;
  for (int t = bidx(); t < 128 * 4; t += gridDim.x) {
    const int mt = t >> 2, nt = t & 3;
    f32x16 acc[4][2];
    zero_acc<4, 2>(acc);
    gemm_mainloop<4, 2>(A + (size_t)mt * 256 * K, K, Bt + (size_t)nt * 256 * K, K, K, lds, acc);
#pragma unroll
    for (int mi = 0; mi < 4; ++mi) {
      const int m = mt * 256 + wm * 128 + mi * 32 + (lane & 31);
#pragma unroll
      for (int ni = 0; ni < 2; ++ni)
#pragma unroll
        for (int q = 0; q < 4; ++q) {
          const int n = nt * 256 + wn * 64 + ni * 32 + q * 8 + (lane >> 5) * 4;
          float* hp = p.hf + (size_t)m * DM + n;
          f32x4 v = *(const f32x4*)hp;
          v[0] = ALPHA * v[0] + acc[mi][ni][q * 4 + 0]; v[1] = ALPHA * v[1] + acc[mi][ni][q * 4 + 1];
          v[2] = ALPHA * v[2] + acc[mi][ni][q * 4 + 2]; v[3] = ALPHA * v[3] + acc[mi][ni][q * 4 + 3];
          *(f32x4*)hp = v;
        }
      asm volatile("" ::: "memory");
    }
  }
}

__device__ void up_phase(const Params& p, char* lds) {
  const int lane = tidx() & 63, wave = tidx() >> 6, wm = wave >> 2, wn = wave & 3;
  for (int t = bidx(); t < 128 * 16; t += gridDim.x) {
    const int mt = t >> 4, nt = t & 15;
    f32x16 acc[4][2];
    zero_acc<4, 2>(acc);
    gemm_mainloop<4, 2>(p.hb + (size_t)mt * 256 * DM, DM, p.WupT + (size_t)nt * 256 * DM, DM, DM, lds, acc);
#pragma unroll
    for (int mi = 0; mi < 4; ++mi) {
      const int m = mt * 256 + wm * 128 + mi * 32 + (lane & 31);
#pragma unroll
      for (int ni = 0; ni < 2; ++ni)
#pragma unroll
        for (int q = 0; q < 4; ++q) {
          const int n = nt * 256 + wn * 64 + ni * 32 + q * 8 + (lane >> 5) * 4;
          float r0 = fmaxf(acc[mi][ni][q * 4 + 0], 0.f), r1 = fmaxf(acc[mi][ni][q * 4 + 1], 0.f), r2 = fmaxf(acc[mi][ni][q * 4 + 2], 0.f), r3 = fmaxf(acc[mi][ni][q * 4 + 3], 0.f);
          u32x2 w; w.x = pk_bf16(r0 * r0, r1 * r1); w.y = pk_bf16(r2 * r2, r3 * r3);
          *(u32x2*)(p.U + (size_t)m * DFF + n) = w;
        }
    }
  }
}


#ifndef DBG_STOP
#define DBG_STOP 0
#endif
#ifndef DBG_QMASK
#define DBG_QMASK 1
#endif
__device__ void dbg_dump(const Params& p, int which) {
  const int tid = tidx();
  for (int m = bidx(); m < MTOK; m += (int)gridDim.x) {
    for (int n = tid; n < 1024; n += NT) {
      float v = 0.f;
      if (which == 1) {
        v = bf2f(p.Z[(size_t)m * 512 + (n & 511)]) + bf2f(p.XBC[(size_t)m * 1024 + n]) + bf2f(p.DNQKV[(size_t)m * 1536 + n]) + bf2f(p.DNQKV[(size_t)m * 1536 + 512 + n])
          + bf2f(p.DNG[(size_t)m * 512 + (n & 511)]) + bf2f(p.SGUV[(size_t)m * 1024 + n]) + bf2f(p.FOXQKV[(size_t)m * 1536 + n]) + bf2f(p.FOXQKV[(size_t)m * 1536 + 512 + n]) + p.small[(size_t)m * 32 + (n & 31)];
      } else if (which == 2) {
        v = p.cbuf[(size_t)(m >> 12) * 8 * SEQL + (size_t)(n & 7) * SEQL + (m & 4095)];
      } else if (which == 3) {
        const int q = n >> 8, c = n & 255;
        if (!((DBG_QMASK >> q) & 1)) { p.hf[(size_t)m * DM + n] = 1.f; continue; }
        if (q == 0) v = bf2f(p.Z[(size_t)m * 512 + c]) + bf2f(p.Z[(size_t)m * 512 + 256 + c]) + p.ssqp[(size_t)(c & 7) * MTOK + m];
        else if (q == 1) v = bf2f(p.DNG[(size_t)m * 512 + c]) + bf2f(p.DNG[(size_t)m * 512 + 256 + c]);
        else if (q == 2) v = bf2f(p.SGUV[(size_t)m * 1024 + c]) + bf2f(p.SGUV[(size_t)m * 1024 + 256 + c]);
        else v = bf2f(p.FOXQKV[(size_t)m * 1536 + c]) + bf2f(p.FOXQKV[(size_t)m * 1536 + 256 + c]);
      } else if (which == 4) {
        v = bf2f(p.XBC[(size_t)m * 1024 + n]);
      } else if (which == 7) {
        v = bf2f(p.U[(size_t)m * 4096 + n]) + bf2f(p.U[(size_t)m * 4096 + 1024 + n]) + bf2f(p.U[(size_t)m * 4096 + 2048 + n]) + bf2f(p.U[(size_t)m * 4096 + 3072 + n]);
      }
      p.hf[(size_t)m * DM + n] = v;
    }
  }
}
#define LAS __attribute__((address_space(3)))
#define XB_TMO      128
#define XB_XCNT(j)  (256  + 64 * (j))
#define XB_XSUB(j)  (1280 + 64 * (j))
#define XB_XGEN(j)  (2304 + 64 * (j))
#define XB_TOP      3328
#define XB_TOPGEN   3392
#define XCD_BAR_WORDS 3456
#define XB_SPIN_CAP (1u << 18)

__device__ __forceinline__ unsigned xb_ld(unsigned* p)              { return __hip_atomic_load(p, __ATOMIC_RELAXED, __HIP_MEMORY_SCOPE_AGENT); }
__device__ __forceinline__ unsigned xb_add(unsigned* p, unsigned v) { return __hip_atomic_fetch_add(p, v, __ATOMIC_RELAXED, __HIP_MEMORY_SCOPE_AGENT); }
__device__ __forceinline__ unsigned xb_xcc_id() { return (unsigned)__builtin_amdgcn_s_getreg((3 << 11) | 20) & 0xFu; }
#define XB_SPIN(cond, bar) do { unsigned _sp = 0; while (cond) { __builtin_amdgcn_s_sleep(1); \
    if ((++_sp & 255u) == 0u) { if (xb_ld(&(bar)[XB_TMO])) break; if (_sp > XB_SPIN_CAP) { atomicAdd(&(bar)[XB_TMO], 1u); break; } } } } while (0)

struct XcdBarrier {
    unsigned* bar; unsigned x;
    volatile LAS unsigned* st;
};

__device__ __forceinline__ XcdBarrier xcd_barrier_post(unsigned* bar, volatile LAS unsigned* st) {
    XcdBarrier b; b.bar = bar; b.x = xb_xcc_id(); b.st = st;
    if (threadIdx.x == 0) (void)xb_add(&bar[XB_XCNT(b.x)], 1u);
    return b;
}
__device__ __forceinline__ void xcd_barrier_complete(unsigned* bar, unsigned x, unsigned& nloc, unsigned& nx) {
    const unsigned G = gridDim.x * gridDim.y * gridDim.z;
    unsigned sum, cnt, mine, sp = 0u;
    for (;;) {
        sum = 0u; cnt = 0u; mine = 0u;
#pragma unroll
        for (unsigned j = 0; j < 16; ++j) { const unsigned c = xb_ld(&bar[XB_XCNT(j)]); sum += c; cnt += (c > 0u) ? 1u : 0u; mine = (j == x) ? c : mine; }
        if (sum == G) break;
        __builtin_amdgcn_s_sleep(1);
        if ((++sp & 255u) == 0u) { if (xb_ld(&bar[XB_TMO])) break; if (sp > XB_SPIN_CAP) { atomicAdd(&bar[XB_TMO], 1u); break; } }
    }
    nloc = mine > 0u ? mine : 1u; nx = cnt > 0u ? cnt : 1u;
}

__device__ __forceinline__ void xcd_barrier(const XcdBarrier& b) {
    asm volatile("s_waitcnt vmcnt(0)" ::: "memory");
    __syncthreads();
    if (threadIdx.x == 0) {
        unsigned* bar = b.bar;
        __builtin_amdgcn_s_waitcnt(0);
        unsigned nloc = b.st[0], nx = b.st[1];
        if (nloc == 0u) { xcd_barrier_complete(bar, b.x, nloc, nx); b.st[0] = nloc; b.st[1] = nx; }
        const unsigned old = xb_add(&bar[XB_XSUB(b.x)], 1u);
        const unsigned gen = old / nloc;
        if (old + 1u == (gen + 1u) * nloc) {
            __builtin_amdgcn_fence(__ATOMIC_RELEASE, "agent");
            asm volatile("s_waitcnt vmcnt(0)" ::: "memory");
            const unsigned og = xb_add(&bar[XB_TOP], 1u);
            const unsigned tg = og / nx;
            if (og + 1u == (tg + 1u) * nx) xb_add(&bar[XB_TOPGEN], 1u);
            else XB_SPIN(xb_ld(&bar[XB_TOPGEN]) == tg, bar);
            __builtin_amdgcn_fence(__ATOMIC_ACQUIRE, "agent");
            xb_add(&bar[XB_XGEN(b.x)], 1u);
            asm volatile("s_waitcnt vmcnt(0)" ::: "memory");
        } else {
            XB_SPIN(xb_ld(&bar[XB_XGEN(b.x)]) == gen, bar);
            __builtin_amdgcn_fence(__ATOMIC_ACQUIRE, "agent");
            asm volatile("s_waitcnt vmcnt(0)" ::: "memory");
        }
    }
    __syncthreads();
}

#define CG_SYNC() do { asm volatile("s_waitcnt vmcnt(0) lgkmcnt(0)" ::: "memory"); grid.sync(); } while (0)
#define GRID_SYNC() xcd_barrier(xb)
__global__ void __launch_bounds__(NT) hybrid_fwd(Params p) {
  extern __shared__ __attribute__((aligned(16))) char smem[];
  cg::grid_group grid = cg::this_grid();
  int* s_item = (int*)smem;
  char* lds = smem + 64;
  PG8_LAS unsigned char* lds3 = (PG8_LAS unsigned char*)smem + 1024;
  volatile LAS unsigned* xst = (volatile LAS unsigned*)((LAS unsigned char*)smem + 16);
  if (threadIdx.x == 0) { xst[0] = 0u; xst[1] = 0u; }
  __syncthreads();
  const XcdBarrier xb = xcd_barrier_post(p.ctrl, xst);
  ln_phase(p.x, nullptr, p.hb, p.ln_in_g, p.ln_in_b);
  convert_weights(p, 0, lds);
  CG_SYNC();
  for (int layer = 0; layer < 2; ++layer) {
    { EpiProj E; E.p = p; pg8_phase(p.hb, p.WinT, NPROJ, DM, E, lds3); }
    GRID_SYNC();
    if (DBG_STOP == 1) { dbg_dump(p, 1); return; }
    conv_phase(p, layer);
    gates_halo_phase(p, layer);
    foxc_phase(p, layer, lds);
    GRID_SYNC();
    if (DBG_STOP == 2) { dbg_dump(p, 2); return; }
    mixer_phase1(p, layer, lds);
    GRID_SYNC();
    mixer_phase2(p, layer, lds, s_item);
    GRID_SYNC();
    if (DBG_STOP == 3) { dbg_dump(p, 3); return; }
    merge_phase(p, layer, lds3);
    GRID_SYNC();
    if (DBG_STOP == 4) { dbg_dump(p, 4); return; }
    { EpiResid E; E.hf = p.hf; E.hb = p.hb; pg8_phase(p.XBC, p.WoT, DM, DM, E, lds3); }
    GRID_SYNC();
    if (DBG_STOP == 5) return;
    ln_phase(p.hf, nullptr, p.hb, p.ln1_g + layer * DM, p.ln1_b + layer * DM);
    GRID_SYNC();
    if (DBG_STOP == 6) return;
    { EpiUp E; E.U = p.U; pg8_phase(p.hb, p.WupT, DFF, DM, E, lds3); }
    GRID_SYNC();
    if (DBG_STOP == 7) { dbg_dump(p, 7); return; }
    { EpiResid E; E.hf = p.hf; E.hb = p.hb; pg8_phase(p.U, p.WdnT, DM, DFF, E, lds3); }
    GRID_SYNC();
    if (DBG_STOP == 8) return;
    ln_phase(p.hf, layer == 1 ? p.hf : nullptr, p.hb, p.ln2_g + layer * DM, p.ln2_b + layer * DM);
    if (DBG_STOP == 9) return;
    if (layer == 0) { convert_weights(p, 1, lds); GRID_SYNC(); }
  }
}

extern "C" void kernel_launch(void* const* d_in, const int* in_sizes, int n_in, void* d_out, int out_size, void* d_ws, size_t ws_size, hipStream_t stream) {
  (void)in_sizes; (void)n_in; (void)out_size;
  Params p{};
  const float* const* in = (const float* const*)d_in;
  p.x = in[0]; p.ln_in_g = in[1]; p.ln_in_b = in[2]; p.w_in = in[3];
  p.ssd_conv_w = in[4]; p.ssd_conv_b = in[5]; p.ssd_dt_bias = in[6]; p.ssd_a_log = in[7]; p.ssd_d = in[8]; p.ssd_norm_w = in[9];
  p.dn_conv_w = in[10]; p.dn_a_log = in[11]; p.dn_dt_bias = in[12]; p.dn_norm_w = in[13];
  p.sg_ln_g = in[14]; p.sg_ln_b = in[15]; p.sg_w = in[16]; p.sg_b = in[17];
  p.fox_f_bias = in[18]; p.gate_b = in[19]; p.w_branch = in[20]; p.w_out = in[21];
  p.ln1_g = in[22]; p.ln1_b = in[23]; p.w_up = in[24]; p.w_down = in[25]; p.ln2_g = in[26]; p.ln2_b = in[27];
  p.hf = (float*)d_out;
  char* ws = (char*)d_ws;
  size_t off = 0;
  auto take = [&](size_t bytes) { char* r = ws + off; off += (bytes + 255) & ~(size_t)255; return r; };
  p.ctrl = (unsigned*)take(16384);
  p.hb = (bf16_t*)take((size_t)MTOK * 1024 * 2);
  char* seg0 = ws + off;
  p.Z = (bf16_t*)take((size_t)MTOK * 512 * 2);
  p.XBC = (bf16_t*)take((size_t)MTOK * 1024 * 2);
  p.DNQKV = (bf16_t*)take((size_t)MTOK * 1536 * 2);
  p.DNG = (bf16_t*)take((size_t)MTOK * 512 * 2);
  p.SGUV = (bf16_t*)take((size_t)MTOK * 1024 * 2);
  p.FOXQKV = (bf16_t*)take((size_t)MTOK * 1536 * 2);
  p.U = (bf16_t*)seg0;
  p.small = (float*)take((size_t)MTOK * 32 * 4);
  p.cbuf = (float*)take((size_t)64 * SEQL * 4);
  p.ssqp = (float*)take((size_t)MTOK * 8 * 4);
  p.halo = (bf16_t*)take((size_t)512 * 3 * 2560 * 2);
  p.WinT = (bf16_t*)take((size_t)NWIN * 1024 * 2);
  p.WbT = (bf16_t*)take((size_t)4 * 1024 * 512 * 2);
  p.WoT = (bf16_t*)take((size_t)1024 * 1024 * 2);
  p.WupT = (bf16_t*)take((size_t)4096 * 1024 * 2);
  p.WdnT = (bf16_t*)take((size_t)1024 * 4096 * 2);
  if (off > ws_size) { fprintf(stderr, "workspace too small: need %zu have %zu\n", off, ws_size); return; }
  static int grid_blocks = 0;
  if (!grid_blocks) {
    hipFuncSetAttribute((const void*)hybrid_fwd, hipFuncAttributeMaxDynamicSharedMemorySize, (int)LDS_BYTES);
    int dev = 0, cus = 0, per_cu = 0;
    hipGetDevice(&dev);
    hipDeviceGetAttribute(&cus, hipDeviceAttributeMultiprocessorCount, dev);
    hipOccupancyMaxActiveBlocksPerMultiprocessor(&per_cu, hybrid_fwd, NT, LDS_BYTES);
    if (per_cu < 1) per_cu = 1;
    grid_blocks = cus * per_cu;
  }
  hipMemsetAsync(p.ctrl, 0, 16384, stream);
  void* args[] = {&p};
  hipError_t e = hipLaunchCooperativeKernel((void*)hybrid_fwd, dim3(grid_blocks), dim3(NT), args, LDS_BYTES, stream);
  if (e != hipSuccess) fprintf(stderr, "cooperative launch failed: %s (grid %d)\n", hipGetErrorString(e), grid_blocks);
}
```

```cpp
#include <hip/hip_runtime.h>
#include <hip/hip_cooperative_groups.h>
#include <cstdio>
#include <cstdint>
namespace cg = cooperative_groups;

typedef unsigned short bf16_t;
typedef short bf16x8 __attribute__((ext_vector_type(8)));
typedef float f32x4 __attribute__((ext_vector_type(4)));
typedef float f32x16 __attribute__((ext_vector_type(16)));
typedef unsigned u32x4 __attribute__((ext_vector_type(4)));
typedef unsigned u32x2 __attribute__((ext_vector_type(2)));

constexpr int NT = 512;
constexpr int MTOK = 32768, SEQL = 4096, DM = 1024, DFF = 4096;
constexpr int DIN = 10264;
constexpr int NPROJ = 6400;
constexpr int NWIN = 6400 + 4096;
constexpr size_t LDS_BYTES = 163840;
constexpr float ALPHA = 1.4142135623730951f;

struct Params {
  const float* x; const float* ln_in_g; const float* ln_in_b; const float* w_in;
  const float* ssd_conv_w; const float* ssd_conv_b; const float* ssd_dt_bias; const float* ssd_a_log; const float* ssd_d; const float* ssd_norm_w;
  const float* dn_conv_w; const float* dn_a_log; const float* dn_dt_bias; const float* dn_norm_w;
  const float* sg_ln_g; const float* sg_ln_b; const float* sg_w; const float* sg_b;
  const float* fox_f_bias; const float* gate_b; const float* w_branch; const float* w_out;
  const float* ln1_g; const float* ln1_b; const float* w_up; const float* w_down; const float* ln2_g; const float* ln2_b;
  float* hf;
  unsigned* ctrl;
  bf16_t* hb;
  bf16_t* Z;
  bf16_t* XBC;
  bf16_t* DNQKV;
  bf16_t* DNG;
  bf16_t* SGUV;
  bf16_t* FOXQKV;
  float* small;
  float* cbuf;
  float* ssqp;
  bf16_t* halo;
  bf16_t* WinT;
  bf16_t* WbT;
  bf16_t* WoT;
  bf16_t* WupT;
  bf16_t* WdnT;
  bf16_t* U;
};

typedef float f32x2_t __attribute__((ext_vector_type(2)));
typedef __bf16 bf16x2_t __attribute__((ext_vector_type(2)));
__device__ __forceinline__ unsigned pk_bf16(float lo, float hi) { f32x2_t v = {lo, hi}; bf16x2_t b = __builtin_convertvector(v, bf16x2_t); unsigned r; __builtin_memcpy(&r, &b, 4); return r; }
__device__ __forceinline__ bf16_t f2bf(float x) { return (bf16_t)(pk_bf16(x, 0.f) & 0xffffu); }
__device__ __forceinline__ float bf2f(bf16_t x) { return __uint_as_float(((unsigned)x) << 16); }
__device__ __forceinline__ float bflo(unsigned w) { return __uint_as_float(w << 16); }
__device__ __forceinline__ float bfhi(unsigned w) { return __uint_as_float(w & 0xffff0000u); }
__device__ __forceinline__ float sigmoidf_(float x) { return 1.f / (1.f + __expf(-x)); }
__device__ __forceinline__ float siluf_(float x) { return x / (1.f + __expf(-x)); }
__device__ __forceinline__ float softplusf_(float x) { return fmaxf(x, 0.f) + log1pf(__expf(-fabsf(x))); }
__device__ __forceinline__ float logsigmoidf_(float x) { return fminf(x, 0.f) - log1pf(__expf(-fabsf(x))); }
__device__ __forceinline__ float geluf_(float x) {
  const float y = 0.7978845608028654f * (x + 0.044715f * x * x * x);
  const float t = 1.f - 2.f / (__expf(2.f * y) + 1.f);
  return 0.5f * x * (1.f + t);
}
__device__ __forceinline__ int opq(int x) { asm("" : "+v"(x)); return x; }
__device__ __forceinline__ int tidx() { int t = threadIdx.x; asm volatile("" : "+v"(t)); return t; }
__device__ __forceinline__ int bidx() { int t = blockIdx.x; asm volatile("" : "+s"(t)); return t; }
__device__ __forceinline__ float wave_sum(float v) {
#pragma unroll
  for (int o = 32; o >= 1; o >>= 1) v += __shfl_xor(v, o);
  return v;
}
__device__ __forceinline__ f32x4 mma16(const bf16_t* P, int ldp, const bf16_t* Q, int ldq, int K, f32x4 acc, int lane) {
  const bf16_t* a = P + (lane & 15) * ldp + (lane >> 4) * 8;
  const bf16_t* b = Q + (lane & 15) * ldq + (lane >> 4) * 8;
  for (int k = 0; k < K; k += 32)
    acc = __builtin_amdgcn_mfma_f32_16x16x32_bf16(*(const bf16x8*)(a + k), *(const bf16x8*)(b + k), acc, 0, 0, 0);
  return acc;
}

template <int MI, int NI>
__device__ __forceinline__ void gemm_mainloop(const bf16_t* __restrict__ A, int lda, const bf16_t* __restrict__ Bt, int ldb, int K,
                                              char* lds, f32x16 (&acc)[MI][NI]) {
  constexpr int BM = 64 * MI, BN = 128 * NI, ACH = MI, BCH = 2 * NI, LDT = 72;
  constexpr int A_BYTES = BM * LDT * 2, B_BYTES = BN * LDT * 2, STAGE = A_BYTES + B_BYTES;
  const int tid = tidx(), lane = tid & 63, wave = tid >> 6, wm = wave >> 2, wn = wave & 3;
  u32x4 ra[ACH], rb[BCH];
  const int nk = K / 64;
  const int lrow = tid >> 3, lkc = (tid & 7) * 8;
  const bf16_t* ga = A + (size_t)lrow * lda + lkc;
  const bf16_t* gb = Bt + (size_t)lrow * ldb + lkc;
#pragma unroll
  for (int i = 0; i < ACH; ++i) ra[i] = *(const u32x4*)(ga + (size_t)(64 * i) * lda);
#pragma unroll
  for (int i = 0; i < BCH; ++i) rb[i] = *(const u32x4*)(gb + (size_t)(64 * i) * ldb);
  {
    char* base = lds;
#pragma unroll
    for (int i = 0; i < ACH; ++i) *(u32x4*)(base + ((lrow + 64 * i) * LDT + lkc) * 2) = ra[i];
#pragma unroll
    for (int i = 0; i < BCH; ++i) *(u32x4*)(base + A_BYTES + ((lrow + 64 * i) * LDT + lkc) * 2) = rb[i];
  }
  __syncthreads();
  const int aoff = ((wm * MI * 32 + (lane & 31)) * LDT + (lane >> 5) * 8) * 2;
  const int boff = A_BYTES + ((wn * NI * 32 + (lane & 31)) * LDT + (lane >> 5) * 8) * 2;
  for (int kt = 0; kt < nk; ++kt) {
    if (kt + 1 < nk) {
#pragma unroll
      for (int i = 0; i < ACH; ++i) ra[i] = *(const u32x4*)(ga + (size_t)(64 * i) * lda + (kt + 1) * 64);
#pragma unroll
      for (int i = 0; i < BCH; ++i) rb[i] = *(const u32x4*)(gb + (size_t)(64 * i) * ldb + (kt + 1) * 64);
    }
    const char* st = lds + (kt & 1) * STAGE;
#pragma unroll
    for (int k16 = 0; k16 < 4; ++k16) {
      bf16x8 a[MI], b[NI];
#pragma unroll
      for (int mi = 0; mi < MI; ++mi) a[mi] = *(const bf16x8*)(st + aoff + (mi * 32 * LDT + k16 * 16) * 2);
#pragma unroll
      for (int ni = 0; ni < NI; ++ni) b[ni] = *(const bf16x8*)(st + boff + (ni * 32 * LDT + k16 * 16) * 2);
#pragma unroll
      for (int mi = 0; mi < MI; ++mi)
#pragma unroll
        for (int ni = 0; ni < NI; ++ni) acc[mi][ni] = __builtin_amdgcn_mfma_f32_32x32x16_bf16(b[ni], a[mi], acc[mi][ni], 0, 0, 0);
    }
    if (kt + 1 < nk) {
      char* base = lds + ((kt + 1) & 1) * STAGE;
#pragma unroll
      for (int i = 0; i < ACH; ++i) *(u32x4*)(base + ((lrow + 64 * i) * LDT + lkc) * 2) = ra[i];
#pragma unroll
      for (int i = 0; i < BCH; ++i) *(u32x4*)(base + A_BYTES + ((lrow + 64 * i) * LDT + lkc) * 2) = rb[i];
    }
    __syncthreads();
  }
}
template <int MI, int NI>
__device__ __forceinline__ void zero_acc(f32x16 (&acc)[MI][NI]) {
#pragma unroll
  for (int mi = 0; mi < MI; ++mi)
#pragma unroll
    for (int ni = 0; ni < NI; ++ni)
#pragma unroll
      for (int r = 0; r < 16; ++r) acc[mi][ni][r] = 0.f;
}

namespace pg8 {
#define PG8_LAS __attribute__((address_space(3)))
constexpr int BM = 256, BK = 64, HALF = 128, HTB = HALF * BK * 2  , STAGE_BYTES = 8 * HTB, NXCD = 8, WGM = 8;

__host__ __device__ __forceinline__ int lds_byte(int r, int c) { const int st = (r >> 4) * 2 + (c >> 5), rr = r & 15, cc = c & 31, ob = rr * 64 + cc * 2; return st * 1024 + (ob ^ (((ob >> 9) & 1) << 5)); }
__host__ __device__ __forceinline__ void stage_rc(int b, int& R, int& C) { const int st = b / 1024, sb = b % 1024, swz = sb ^ (((sb >> 9) & 1) << 5); R = (st >> 1) * 16 + swz / 64; C = (st & 1) * 32 + (swz % 64) / 2; }
__host__ __device__ __forceinline__ int perm32(int rho) { const int n = rho >> 4, i = rho & 15; return 8 * (i >> 2) + 4 * n + (i & 3); }
struct Unit { int pm, pn; };
struct Gemm { const bf16_t* A; const bf16_t* Bt; int M, N, K; };

struct StaticOrder {
    int nM, nN, nwg, G, c;
    __host__ __device__ void init(int M, int N, int G_, int c_) { nM = M / BM; nN = N / BM; nwg = nM * nN; G = G_; c = c_; }
    __host__ __device__ bool next(int i, Unit& u) const {
        const long L = (long)i * G + c; if (L >= nwg) return false;
        int wgid = (int)L; { const int q = nwg / NXCD, r = nwg % NXCD, xcd = wgid % NXCD, off = wgid / NXCD; wgid = (xcd < r ? xcd * (q + 1) : r * (q + 1) + (xcd - r) * q) + off; }
        const int nig = WGM * nN, gid = wgid / nig, fm = gid * WGM, gsz = (nM - fm) < WGM ? (nM - fm) : WGM;
        u.pm = fm + ((wgid % nig) % gsz); u.pn = (wgid % nig) / gsz; return true;
    }
    __device__ __forceinline__ void a_ready(const Unit&) const {}
    __device__ __forceinline__ void done(const Unit&) const {}
};
template <class Epi, class Sched, bool ALIGN_EPI = false, bool SP2 = false>
__device__ __forceinline__ void gemm_phase(PG8_LAS unsigned char* lds, const Gemm g, const Sched& S, const Epi& E) {
    const int tid = tidx(), wid = __builtin_amdgcn_readfirstlane(tid >> 6), lane = tid & 63, wr = wid >> 2, wc = wid & 3, fr = lane & 15, fq = lane >> 4;
    const int K = g.K, nt = K / BK;
    unsigned voffA[2], voffB[2];
#pragma unroll
    for (int i = 0; i < 2; ++i) { int R, C; stage_rc(tid * 16 + i * 8192, R, C); const int Rb = Epi::PERM ? ((R & ~31) + perm32(R & 31)) : R;
        voffA[i] = (unsigned)(R * K + C) * 2u; voffB[i] = (unsigned)(Rb * K + C) * 2u; }
    const size_t kstep = (size_t)(BK * 2);
    const size_t hstep = (size_t)HALF * K * 2;
    const size_t tstep = 2 * hstep;
    const unsigned ldsw = (unsigned)wid * 1024u;
    const int aoff = lds_byte(wr * 64 + fr, fq * 8), boff = lds_byte(wc * 32 + fr, fq * 8);
#define PG8_SA(b, h) (((b) * 2 + (h)) * HTB)
#define PG8_SB(b, h) ((4 + (b) * 2 + (h)) * HTB)
#define PG8_STAGE(bufoff, gbase, voff) do { _Pragma("unroll") for (int _i = 0; _i < 2; ++_i) \
        __builtin_amdgcn_global_load_lds((const unsigned*)((const char*)(gbase) + (voff)[_i]), (PG8_LAS unsigned*)(lds + (bufoff) + ldsw + _i * 8192), 16, 0, 0); } while (0)
#define PG8_LDA(dst, b, h) do { _Pragma("unroll") for (int m = 0; m < 4; ++m) _Pragma("unroll") for (int k = 0; k < 2; ++k) dst[m][k] = *(const PG8_LAS bf16x8*)(lds + PG8_SA(b, h) + aoff + m * 2048 + k * 1024); } while (0)
#define PG8_LDB(dst, b, h) do { _Pragma("unroll") for (int n = 0; n < 2; ++n) _Pragma("unroll") for (int k = 0; k < 2; ++k) dst[n][k] = *(const PG8_LAS bf16x8*)(lds + PG8_SB(b, h) + boff + n * 2048 + k * 1024); } while (0)
#define PG8_MMA(ai, bj, At, Bt) do { __builtin_amdgcn_s_setprio(1); _Pragma("unroll") for (int m = 0; m < 4; ++m) _Pragma("unroll") for (int n = 0; n < 2; ++n) _Pragma("unroll") for (int k = 0; k < 2; ++k) \
        acc[ai][bj][m][n] = __builtin_amdgcn_mfma_f32_16x16x32_bf16(Bt[n][k], At[m][k], acc[ai][bj][m][n], 0, 0, 0); __builtin_amdgcn_s_setprio(0); } while (0)
#define PG8_WAIT_V(n) asm volatile("s_waitcnt vmcnt(" #n ")" ::: "memory")
#define PG8_WAIT_L(n) asm volatile("s_waitcnt lgkmcnt(" #n ")" ::: "memory")
#define PG8_BAR __builtin_amdgcn_s_barrier()
#define PG8_SCHED __builtin_amdgcn_sched_barrier(0)
    Unit cur, nxt; int ui = 0;
    if (!S.next(0, cur)) return;
    f32x4 acc[2][2][4][2];
#pragma unroll
    for (int a = 0; a < 2; ++a)
#pragma unroll
        for (int b = 0; b < 2; ++b)
#pragma unroll
            for (int m = 0; m < 4; ++m)
#pragma unroll
                for (int n = 0; n < 2; ++n) acc[a][b][m][n] = (f32x4){0.f, 0.f, 0.f, 0.f};
    bf16x8 At[4][2], B0[2][2], B1[2][2];
    const char* cA = (const char*)g.A + (size_t)cur.pm * tstep; const char* cB = (const char*)g.Bt + (size_t)cur.pn * tstep;
    S.a_ready(cur);
    if constexpr (SP2) {
        PG8_STAGE(PG8_SB(0, 0), cB, voffB); PG8_STAGE(PG8_SB(0, 1), cB + hstep, voffB); PG8_STAGE(PG8_SA(0, 0), cA, voffA); PG8_STAGE(PG8_SA(0, 1), cA + hstep, voffA);
        if (wr == 1) PG8_BAR;
        PG8_WAIT_V(2); PG8_BAR;
        PG8_STAGE(PG8_SB(1, 0), cB + kstep, voffB); PG8_STAGE(PG8_SA(1, 0), cA + kstep, voffA); PG8_STAGE(PG8_SB(1, 1), cB + hstep + kstep, voffB);
        PG8_WAIT_V(6); PG8_BAR;
    } else {
        PG8_STAGE(PG8_SB(0, 0), cB, voffB); PG8_STAGE(PG8_SA(0, 0), cA, voffA); PG8_STAGE(PG8_SB(0, 1), cB + hstep, voffB); PG8_STAGE(PG8_SA(0, 1), cA + hstep, voffA);
        if (wr == 1) PG8_BAR;
        PG8_WAIT_V(4); PG8_BAR;
        PG8_STAGE(PG8_SB(1, 0), cB + kstep, voffB); PG8_STAGE(PG8_SA(1, 0), cA + kstep, voffA); PG8_STAGE(PG8_SB(1, 1), cB + hstep + kstep, voffB);
        PG8_WAIT_V(6); PG8_BAR;
    }
    for (;;) {
        const bool has_next = S.next(ui + 1, nxt);
        const char* nA = has_next ? (const char*)g.A + (size_t)nxt.pm * tstep : cA; const char* nB = has_next ? (const char*)g.Bt + (size_t)nxt.pn * tstep : cB;
        for (int t = 0; t < nt; t += 2) {
            const bool last = (t == nt - 2);
            const char* a1 = cA + (size_t)(t + 1) * kstep;
            const char* a2 = last ? nA : cA + (size_t)(t + 2) * kstep; const char* b2 = last ? nB : cB + (size_t)(t + 2) * kstep;
            const char* a3 = a2 + kstep; const char* b3 = b2 + kstep;
            if (last && has_next) S.a_ready(nxt);
            if constexpr (SP2) {
            PG8_LDB(B0, 0, 0); PG8_LDB(B1, 0, 1); PG8_SCHED; PG8_LDA(At, 0, 0); PG8_STAGE(PG8_SA(1, 1), a1 + hstep, voffA);
            PG8_WAIT_V(8); PG8_WAIT_L(0); PG8_BAR; PG8_MMA(0, 0, At, B0); PG8_MMA(0, 1, At, B1); PG8_BAR; PG8_SCHED;
            PG8_LDA(At, 0, 1); PG8_STAGE(PG8_SB(0, 0), b2, voffB); PG8_STAGE(PG8_SB(0, 1), b2 + hstep, voffB); PG8_STAGE(PG8_SA(0, 0), a2, voffA);
            PG8_WAIT_V(8); PG8_WAIT_L(0); PG8_BAR; PG8_MMA(1, 0, At, B0); PG8_MMA(1, 1, At, B1); PG8_BAR; PG8_SCHED;
            PG8_LDB(B0, 1, 0); PG8_LDB(B1, 1, 1); PG8_SCHED; PG8_LDA(At, 1, 0); PG8_STAGE(PG8_SA(0, 1), a2 + hstep, voffA);
            PG8_WAIT_V(8); PG8_WAIT_L(0); PG8_BAR; PG8_MMA(0, 0, At, B0); PG8_MMA(0, 1, At, B1); PG8_BAR; PG8_SCHED;
            PG8_LDA(At, 1, 1); PG8_STAGE(PG8_SB(1, 0), b3, voffB); PG8_STAGE(PG8_SB(1, 1), b3 + hstep, voffB); PG8_STAGE(PG8_SA(1, 0), a3, voffA);
            PG8_WAIT_V(8); PG8_WAIT_L(0); PG8_BAR; PG8_MMA(1, 0, At, B0); PG8_MMA(1, 1, At, B1); PG8_BAR; PG8_SCHED;
            } else {
            PG8_LDB(B0, 0, 0); PG8_SCHED; PG8_LDA(At, 0, 0); PG8_STAGE(PG8_SA(1, 1), a1 + hstep, voffA);
            PG8_WAIT_L(8); PG8_BAR; PG8_WAIT_L(0); PG8_MMA(0, 0, At, B0); PG8_BAR; PG8_SCHED;
            PG8_LDB(B1, 0, 1); PG8_STAGE(PG8_SB(0, 0), b2, voffB);
            PG8_BAR; PG8_WAIT_L(0); PG8_MMA(0, 1, At, B1); PG8_BAR;
            PG8_LDA(At, 0, 1); PG8_STAGE(PG8_SA(0, 0), a2, voffA);
            PG8_BAR; PG8_WAIT_L(0); PG8_MMA(1, 0, At, B0); PG8_BAR; PG8_SCHED;
            PG8_STAGE(PG8_SB(0, 1), b2 + hstep, voffB);
            PG8_WAIT_V(6); PG8_BAR; PG8_MMA(1, 1, At, B1); PG8_BAR;
            PG8_LDB(B0, 1, 0); PG8_SCHED; PG8_LDA(At, 1, 0); PG8_STAGE(PG8_SA(0, 1), a2 + hstep, voffA);
            PG8_WAIT_L(8); PG8_BAR; PG8_WAIT_L(0); PG8_MMA(0, 0, At, B0); PG8_BAR; PG8_SCHED;
            PG8_LDB(B1, 1, 1); PG8_STAGE(PG8_SB(1, 0), b3, voffB);
            PG8_BAR; PG8_WAIT_L(0); PG8_MMA(0, 1, At, B1); PG8_BAR;
            PG8_LDA(At, 1, 1); PG8_STAGE(PG8_SA(1, 0), a3, voffA);
            PG8_BAR; PG8_WAIT_L(0); PG8_MMA(1, 0, At, B0); PG8_BAR; PG8_SCHED;
            PG8_STAGE(PG8_SB(1, 1), b3 + hstep, voffB);
            PG8_WAIT_V(6); PG8_BAR; PG8_MMA(1, 1, At, B1); PG8_BAR;
            }
        }
        if constexpr (ALIGN_EPI) { if (wr == 0) PG8_BAR; }
        if constexpr (!Epi::AFTER_DRAIN) { E(acc, cur, wr, wc, fr, fq); S.done(cur); }
        if (!has_next) break;
#pragma unroll
        for (int a = 0; a < 2; ++a)
#pragma unroll
            for (int b = 0; b < 2; ++b)
#pragma unroll
                for (int m = 0; m < 4; ++m)
#pragma unroll
                    for (int n = 0; n < 2; ++n) acc[a][b][m][n] = (f32x4){0.f, 0.f, 0.f, 0.f};
        cur = nxt; cA = nA; cB = nB; ++ui;
        if constexpr (ALIGN_EPI) { if (wr == 1) PG8_BAR; }
    }
    PG8_WAIT_V(0);
    if constexpr (!ALIGN_EPI) { if (wr == 0) PG8_BAR; }
    PG8_BAR;
    if constexpr (Epi::AFTER_DRAIN) { E.fused(acc, cur, wr, wc, fr, fq, lds, wid, lane); S.done(cur); }
#undef PG8_SA
#undef PG8_SB
#undef PG8_STAGE
#undef PG8_LDA
#undef PG8_LDB
#undef PG8_MMA
#undef PG8_WAIT_V
#undef PG8_WAIT_L
#undef PG8_BAR
#undef PG8_SCHED
}
}


template <int MI, int NI, bool PERMB = false>
__device__ __forceinline__ void gemm_mainloop_dma(const bf16_t* __restrict__ A, int lda, const bf16_t* __restrict__ Bt, int ldb, int K,
                                                  PG8_LAS unsigned char* lds3, f32x16 (&acc)[MI][NI]) {
  constexpr int BM = 64 * MI, BN = 128 * NI;
  constexpr int A_BYTES = BM * 128, B_BYTES = BN * 128, STAGE = A_BYTES + B_BYTES;
  constexpr int APIECES = BM / 8 / 8, BPIECES = BN / 8 / 8;
  const int tid = tidx(), lane = tid & 63, wave = __builtin_amdgcn_readfirstlane(tid >> 6), wm = wave >> 2, wn = wave & 3;
  const int nk = K / 64;
  const int prow = lane >> 3;
  unsigned offA[APIECES], offB[BPIECES];
#pragma unroll
  for (int i = 0; i < APIECES; ++i) { const int row = (wave * APIECES + i) * 8 + prow; offA[i] = (unsigned)(row * lda + (((lane & 7) ^ ((row >> 1) & 7)) * 8)); }
#pragma unroll
  for (int i = 0; i < BPIECES; ++i) { const int row = (wave * BPIECES + i) * 8 + prow; const int grow = PERMB ? (((row >> 5) & 1) * 128 + (row >> 6) * 32 + (row & 31)) : row;
    offB[i] = (unsigned)(grow * ldb + (((lane & 7) ^ ((row >> 1) & 7)) * 8)); }
  auto stage = [&](int st, int kt) {
    PG8_LAS unsigned char* base = lds3 + st * STAGE;
#pragma unroll
    for (int i = 0; i < APIECES; ++i)
      __builtin_amdgcn_global_load_lds((const unsigned*)(A + offA[i] + kt * 64), (PG8_LAS unsigned*)(base + (wave * APIECES + i) * 1024), 16, 0, 0);
#pragma unroll
    for (int i = 0; i < BPIECES; ++i)
      __builtin_amdgcn_global_load_lds((const unsigned*)(Bt + offB[i] + kt * 64), (PG8_LAS unsigned*)(base + A_BYTES + (wave * BPIECES + i) * 1024), 16, 0, 0);
  };
  stage(0, 0);
  asm volatile("s_waitcnt vmcnt(0)" ::: "memory");
  __builtin_amdgcn_s_barrier();
  const int ar = wm * MI * 32 + (lane & 31), br = wn * NI * 32 + (lane & 31), ch = lane >> 5;
  for (int kt = 0; kt < nk; ++kt) {
    if (kt + 1 < nk) stage((kt + 1) & 1, kt + 1);
    PG8_LAS const unsigned char* sa = lds3 + (kt & 1) * STAGE;
    PG8_LAS const unsigned char* sb = sa + A_BYTES;
#pragma unroll
    for (int k16 = 0; k16 < 4; ++k16) {
      bf16x8 a[MI], b[NI];
#pragma unroll
      for (int mi = 0; mi < MI; ++mi) { const int r = ar + mi * 32; a[mi] = *(PG8_LAS const bf16x8*)(sa + r * 128 + (((k16 * 2 + ch) ^ ((r >> 1) & 7)) * 16)); }
#pragma unroll
      for (int ni = 0; ni < NI; ++ni) { const int r = br + ni * 32; b[ni] = *(PG8_LAS const bf16x8*)(sb + r * 128 + (((k16 * 2 + ch) ^ ((r >> 1) & 7)) * 16)); }
#pragma unroll
      for (int mi = 0; mi < MI; ++mi)
#pragma unroll
        for (int ni = 0; ni < NI; ++ni) acc[mi][ni] = __builtin_amdgcn_mfma_f32_32x32x16_bf16(b[ni], a[mi], acc[mi][ni], 0, 0, 0);
    }
    asm volatile("s_waitcnt vmcnt(0) lgkmcnt(0)" ::: "memory");
    __builtin_amdgcn_s_barrier();
  }
}


template <int MI, int NI>
__device__ __forceinline__ void gemm_mainloop_dma128(const bf16_t* __restrict__ A, int lda, const bf16_t* __restrict__ Bt, int ldb, int K,
                                                     PG8_LAS unsigned char* lds3, f32x16 (&acc)[MI][NI]) {
  constexpr int BM = 64 * MI, BN = 128 * NI;
  constexpr int A_BYTES = BM * 256, B_BYTES = BN * 256, STAGE = A_BYTES + B_BYTES;
  constexpr int APIECES = BM / 4 / 8, BPIECES = BN / 4 / 8;
  const int tid = tidx(), lane = tid & 63, wave = __builtin_amdgcn_readfirstlane(tid >> 6), wm = wave >> 2, wn = wave & 3;
  const int nk = K / 128;
  const int prow = lane >> 4;
  unsigned offA[APIECES], offB[BPIECES];
#pragma unroll
  for (int i = 0; i < APIECES; ++i) { const int row = (wave * APIECES + i) * 4 + prow; offA[i] = (unsigned)(row * lda + (((lane & 15) ^ (row & 15)) * 8)); }
#pragma unroll
  for (int i = 0; i < BPIECES; ++i) { const int row = (wave * BPIECES + i) * 4 + prow; offB[i] = (unsigned)(row * ldb + (((lane & 15) ^ (row & 15)) * 8)); }
  auto stage = [&](int st, int kt) {
    PG8_LAS unsigned char* base = lds3 + st * STAGE;
#pragma unroll
    for (int i = 0; i < APIECES; ++i)
      __builtin_amdgcn_global_load_lds((const unsigned*)(A + offA[i] + kt * 128), (PG8_LAS unsigned*)(base + (wave * APIECES + i) * 1024), 16, 0, 0);
#pragma unroll
    for (int i = 0; i < BPIECES; ++i)
      __builtin_amdgcn_global_load_lds((const unsigned*)(Bt + offB[i] + kt * 128), (PG8_LAS unsigned*)(base + A_BYTES + (wave * BPIECES + i) * 1024), 16, 0, 0);
  };
  stage(0, 0);
  asm volatile("s_waitcnt vmcnt(0)" ::: "memory");
  __builtin_amdgcn_s_barrier();
  const int ar = wm * MI * 32 + (lane & 31), br = wn * NI * 32 + (lane & 31), ch = lane >> 5;
  for (int kt = 0; kt < nk; ++kt) {
    if (kt + 1 < nk) stage((kt + 1) & 1, kt + 1);
    PG8_LAS const unsigned char* sa = lds3 + (kt & 1) * STAGE;
    PG8_LAS const unsigned char* sb = sa + A_BYTES;
#pragma unroll
    for (int k16 = 0; k16 < 8; ++k16) {
      bf16x8 a[MI], b[NI];
#pragma unroll
      for (int mi = 0; mi < MI; ++mi) { const int r = ar + mi * 32; a[mi] = *(PG8_LAS const bf16x8*)(sa + r * 256 + (((k16 * 2 + ch) ^ (r & 15)) * 16)); }
#pragma unroll
      for (int ni = 0; ni < NI; ++ni) { const int r = br + ni * 32; b[ni] = *(PG8_LAS const bf16x8*)(sb + r * 256 + (((k16 * 2 + ch) ^ (r & 15)) * 16)); }
#pragma unroll
      for (int mi = 0; mi < MI; ++mi)
#pragma unroll
        for (int ni = 0; ni < NI; ++ni) acc[mi][ni] = __builtin_amdgcn_mfma_f32_32x32x16_bf16(b[ni], a[mi], acc[mi][ni], 0, 0, 0);
    }
    asm volatile("s_waitcnt vmcnt(0) lgkmcnt(0)" ::: "memory");
    __builtin_amdgcn_s_barrier();
  }
}

__device__ __forceinline__ int map_win(int n) {
  if (n < 1536) return n;
  if (n < 3072) return n + 8;
  if (n < 6144) return n + 16;
  if (n < 6400) { const int j = n - 6144; if (j < 8) return 1536 + j; if (j < 12) return 3080 + (j - 8); if (j < 16) return 3084 + (j - 12); if (j < 24) return 6160 + (j - 16); return -1; }
  return n - 6400 + 6168;
}
__device__ void convert_tile(const float* __restrict__ src, int ldsrc, int K, bf16_t* __restrict__ dst, int nb, int kb, bool win, float* ls) {
  const int tid = tidx();
  {
    const int n = tid & 63, kk = tid >> 6;
    const int nd = nb * 64 + n;
    const int col = win ? map_win(nd) : nd;
#pragma unroll
    for (int i = 0; i < 8; ++i) {
      const int k = kk + 8 * i;
      ls[k * 65 + n] = (col >= 0) ? src[(size_t)(kb * 64 + k) * ldsrc + col] : 0.f;
    }
  }
  __syncthreads();
  {
    const int n = tid >> 3, ks = (tid & 7) * 8;
    u32x4 w;
    w.x = pk_bf16(ls[(ks + 0) * 65 + n], ls[(ks + 1) * 65 + n]);
    w.y = pk_bf16(ls[(ks + 2) * 65 + n], ls[(ks + 3) * 65 + n]);
    w.z = pk_bf16(ls[(ks + 4) * 65 + n], ls[(ks + 5) * 65 + n]);
    w.w = pk_bf16(ls[(ks + 6) * 65 + n], ls[(ks + 7) * 65 + n]);
    *(u32x4*)(dst + (size_t)(nb * 64 + n) * K + kb * 64 + ks) = w;
  }
  __syncthreads();
}
__device__ void convert_weights(const Params& p, int layer, char* lds) {
  float* ls = (float*)lds;
  constexpr int T0 = 164 * 16, T1 = T0 + 4 * 16 * 8, T2 = T1 + 256, T3 = T2 + 1024, T4 = T3 + 1024;
  for (int t = bidx(); t < T4; t += gridDim.x) {
    if (t < T0) { convert_tile(p.w_in + (size_t)layer * DM * DIN, DIN, 1024, p.WinT, t >> 4, t & 15, true, ls); }
    else if (t < T1) { const int u = t - T0, br = u >> 7, v = u & 127; convert_tile(p.w_branch + ((size_t)(layer * 4 + br)) * 512 * 1024, 1024, 512, p.WbT + (size_t)br * 1024 * 512, v >> 3, v & 7, false, ls); }
    else if (t < T2) { const int u = t - T1; convert_tile(p.w_out + (size_t)layer * 1024 * 1024, 1024, 1024, p.WoT, u >> 4, u & 15, false, ls); }
    else if (t < T3) { const int u = t - T2; convert_tile(p.w_up + (size_t)layer * 1024 * 4096, 4096, 1024, p.WupT, u >> 4, u & 15, false, ls); }
    else { const int u = t - T3; convert_tile(p.w_down + (size_t)layer * 4096 * 1024, 1024, 4096, p.WdnT, u >> 6, u & 63, false, ls); }
  }
}

__device__ void ln_phase(const float* src, float* dstf, bf16_t* __restrict__ dstb, const float* __restrict__ g, const float* __restrict__ b) {
  const int lane = tidx() & 63, gw = bidx() * 8 + (tidx() >> 6), nw = gridDim.x * 8;
  f32x4 gv[4], bv[4];
#pragma unroll
  for (int i = 0; i < 4; ++i) { gv[i] = *(const f32x4*)(g + i * 256 + lane * 4); bv[i] = *(const f32x4*)(b + i * 256 + lane * 4); }
  f32x4 nx[4];
  if (gw < MTOK) {
#pragma unroll
    for (int i = 0; i < 4; ++i) nx[i] = *(const f32x4*)(src + (size_t)gw * DM + i * 256 + lane * 4);
  }
  for (int row = gw; row < MTOK; row += nw) {
    f32x4 v[4];
#pragma unroll
    for (int i = 0; i < 4; ++i) v[i] = nx[i];
    if (row + nw < MTOK) {
#pragma unroll
      for (int i = 0; i < 4; ++i) nx[i] = *(const f32x4*)(src + (size_t)(row + nw) * DM + i * 256 + lane * 4);
    }
    float s = 0.f;
#pragma unroll
    for (int i = 0; i < 4; ++i) s += (v[i][0] + v[i][1]) + (v[i][2] + v[i][3]);
    const float mu = wave_sum(s) * (1.f / 1024.f);
    float q = 0.f;
#pragma unroll
    for (int i = 0; i < 4; ++i) { v[i] = v[i] - mu; q += (v[i][0] * v[i][0] + v[i][1] * v[i][1]) + (v[i][2] * v[i][2] + v[i][3] * v[i][3]); }
    const float rstd = rsqrtf(wave_sum(q) * (1.f / 1024.f) + 1e-5f);
#pragma unroll
    for (int i = 0; i < 4; ++i) {
      f32x4 y = v[i] * rstd * gv[i] + bv[i];
      if (dstf) *(f32x4*)(dstf + (size_t)row * DM + i * 256 + lane * 4) = y;
      u32x2 w; w.x = pk_bf16(y[0], y[1]); w.y = pk_bf16(y[2], y[3]);
      *(u32x2*)(dstb + (size_t)row * DM + i * 256 + lane * 4) = w;
    }
  }
}

__device__ void inproj_phase(const Params& p, char* lds) {
  const int lane = tidx() & 63, wave = tidx() >> 6, wm = wave >> 2, wn = wave & 3;
  constexpr int NTN = NPROJ / 256;
  for (int t = bidx(); t < 128 * NTN; t += gridDim.x) {
    const int mt = t / NTN, nt = t % NTN, n0 = nt * 256;
    f32x16 acc[4][2];
    zero_acc<4, 2>(acc);
    gemm_mainloop<4, 2>(p.hb + (size_t)mt * 256 * DM, DM, p.WinT + (size_t)n0 * DM, DM, DM, lds, acc);
    bf16_t* dst; int ld, off;
    if (n0 < 512) { dst = p.Z; ld = 512; off = n0; }
    else if (n0 < 1536) { dst = p.XBC; ld = 1024; off = n0 - 512; }
    else if (n0 < 3072) { dst = p.DNQKV; ld = 1536; off = n0 - 1536; }
    else if (n0 < 3584) { dst = p.DNG; ld = 512; off = n0 - 3072; }
    else if (n0 < 4608) { dst = p.SGUV; ld = 1024; off = n0 - 3584; }
    else if (n0 < 6144) { dst = p.FOXQKV; ld = 1536; off = n0 - 4608; }
    else { dst = nullptr; ld = 0; off = 0; }
#pragma unroll
    for (int mi = 0; mi < 4; ++mi) {
      const int m = mt * 256 + wm * 128 + mi * 32 + (lane & 31);
#pragma unroll
      for (int ni = 0; ni < 2; ++ni)
#pragma unroll
        for (int q = 0; q < 4; ++q) {
          const int n = wn * 64 + ni * 32 + q * 8 + (lane >> 5) * 4;
          if (dst) {
            u32x2 w; w.x = pk_bf16(acc[mi][ni][q * 4 + 0], acc[mi][ni][q * 4 + 1]); w.y = pk_bf16(acc[mi][ni][q * 4 + 2], acc[mi][ni][q * 4 + 3]);
            *(u32x2*)(dst + (size_t)m * ld + off + n) = w;
          } else if (n < 32) {
            f32x4 v = {acc[mi][ni][q * 4 + 0], acc[mi][ni][q * 4 + 1], acc[mi][ni][q * 4 + 2], acc[mi][ni][q * 4 + 3]};
            *(f32x4*)(p.small + (size_t)m * 32 + n) = v;
          }
        }
    }
  }
}


struct EpiProj {
  static constexpr bool PERM = true, AFTER_DRAIN = false;
  Params p;
  __device__ __forceinline__ void operator()(const f32x4 (&acc)[2][2][4][2], const pg8::Unit& u, int wr, int wc, int fr, int fq) const {
    const int n0 = u.pn * 256;
    bf16_t* dst; int ld, off;
    if (n0 < 512) { dst = p.Z; ld = 512; off = n0; }
    else if (n0 < 1536) { dst = p.XBC; ld = 1024; off = n0 - 512; }
    else if (n0 < 3072) { dst = p.DNQKV; ld = 1536; off = n0 - 1536; }
    else if (n0 < 3584) { dst = p.DNG; ld = 512; off = n0 - 3072; }
    else if (n0 < 4608) { dst = p.SGUV; ld = 1024; off = n0 - 3584; }
    else if (n0 < 6144) { dst = p.FOXQKV; ld = 1536; off = n0 - 4608; }
    else { dst = nullptr; ld = 0; off = 0; }
    const int hch = (n0 >= 512 && n0 < 1536) ? (n0 - 512) : (n0 >= 1536 && n0 < 3072) ? (1024 + n0 - 1536) : -1;
#pragma unroll
    for (int ai = 0; ai < 2; ++ai)
#pragma unroll
      for (int m = 0; m < 4; ++m) {
        const size_t r = (size_t)u.pm * 256 + ai * 128 + wr * 64 + m * 16 + fr;
#pragma unroll
        for (int bj = 0; bj < 2; ++bj) {
          const int c = bj * 128 + wc * 32 + fq * 8;
          const f32x4 v0 = acc[ai][bj][m][0], v1 = acc[ai][bj][m][1];
          if (dst) {
            u32x4 w; w.x = pk_bf16(v0[0], v0[1]); w.y = pk_bf16(v0[2], v0[3]); w.z = pk_bf16(v1[0], v1[1]); w.w = pk_bf16(v1[2], v1[3]);
            *(u32x4*)(dst + r * ld + off + c) = w;
            if (hch >= 0 && ((int)r & 63) >= 61) {
              const int rr = ((int)r >> 6) + 1;
              if (rr < 512 && (rr & 63) != 0) *(u32x4*)(p.halo + ((size_t)rr * 3 + (((int)r & 63) - 61)) * 2560 + hch + c) = w;
            }
          } else if (c < 32) {
            *(f32x4*)(p.small + r * 32 + c) = v0; *(f32x4*)(p.small + r * 32 + c + 4) = v1;
          }
        }
      }
  }
};
struct EpiUp {
  static constexpr bool PERM = true, AFTER_DRAIN = false;
  bf16_t* U;
  __device__ __forceinline__ void operator()(const f32x4 (&acc)[2][2][4][2], const pg8::Unit& u, int wr, int wc, int fr, int fq) const {
#pragma unroll
    for (int ai = 0; ai < 2; ++ai)
#pragma unroll
      for (int m = 0; m < 4; ++m) {
        const size_t r = (size_t)u.pm * 256 + ai * 128 + wr * 64 + m * 16 + fr;
#pragma unroll
        for (int bj = 0; bj < 2; ++bj) {
          const int c = u.pn * 256 + bj * 128 + wc * 32 + fq * 8;
          f32x4 v0 = acc[ai][bj][m][0], v1 = acc[ai][bj][m][1];
#pragma unroll
          for (int j = 0; j < 4; ++j) { v0[j] = fmaxf(v0[j], 0.f); v0[j] *= v0[j]; v1[j] = fmaxf(v1[j], 0.f); v1[j] *= v1[j]; }
          u32x4 w; w.x = pk_bf16(v0[0], v0[1]); w.y = pk_bf16(v0[2], v0[3]); w.z = pk_bf16(v1[0], v1[1]); w.w = pk_bf16(v1[2], v1[3]);
          *(u32x4*)(U + r * DFF + c) = w;
        }
      }
  }
};
struct EpiResid {
  static constexpr bool PERM = true, AFTER_DRAIN = false;
  float* hf; const bf16_t* hb;
  __device__ __forceinline__ void operator()(const f32x4 (&acc)[2][2][4][2], const pg8::Unit& u, int wr, int wc, int fr, int fq) const {
#pragma unroll
    for (int ai = 0; ai < 2; ++ai) {
#pragma unroll
      for (int m = 0; m < 4; ++m) {
        const size_t r = (size_t)u.pm * 256 + ai * 128 + wr * 64 + m * 16 + fr;
#pragma unroll
        for (int bj = 0; bj < 2; ++bj) {
          const int c = u.pn * 256 + bj * 128 + wc * 32 + fq * 8;
          const u32x4 hv = *(const u32x4*)(hb + r * DM + c);
          f32x4 a = {bflo(hv.x), bfhi(hv.x), bflo(hv.y), bfhi(hv.y)}, b = {bflo(hv.z), bfhi(hv.z), bflo(hv.w), bfhi(hv.w)};
          a = a * ALPHA + acc[ai][bj][m][0]; b = b * ALPHA + acc[ai][bj][m][1];
          float* hp = hf + r * DM + c;
          *(f32x4*)hp = a; *(f32x4*)(hp + 4) = b;
        }
      }
      asm volatile("" ::: "memory");
    }
  }
};
template <class Epi>
__device__ __forceinline__ void pg8_phase(const bf16_t* A, const bf16_t* Bt, int N, int K, const Epi& E, PG8_LAS unsigned char* lds3) {
  pg8::Gemm g; g.A = A; g.Bt = Bt; g.M = MTOK; g.N = N; g.K = K;
  pg8::StaticOrder S; S.init(MTOK, N, (int)gridDim.x, bidx());
  pg8::gemm_phase<Epi, pg8::StaticOrder, true, true>(lds3, g, S, E);
  __syncthreads();
}

__device__ void foxc_phase(const Params& p, int layer, char* lds) {
  float* wsum = (float*)lds;
  const int tid = tidx(), lane = tid & 63, wave = tid >> 6;
  for (int it = bidx(); it < 64; it += gridDim.x) {
    const int b = it >> 3, h = it & 7;
    const float fb = p.fox_f_bias[layer * 8 + h];
    float v[8]; float s = 0.f;
#pragma unroll
    for (int i = 0; i < 8; ++i) { const int l = tid * 8 + i; v[i] = logsigmoidf_(p.small[(size_t)(b * SEQL + l) * 32 + 16 + h] + fb); s += v[i]; }
    float inc = s;
#pragma unroll
    for (int o = 1; o < 64; o <<= 1) { const float t = __shfl_up(inc, o); if (lane >= o) inc += t; }
    if (lane == 63) wsum[wave] = inc;
    __syncthreads();
    float base = inc - s;
    for (int w = 0; w < wave; ++w) base += wsum[w];
    float c = base;
    float* out = p.cbuf + (size_t)it * SEQL + tid * 8;
#pragma unroll
    for (int i = 0; i < 8; ++i) { c += v[i]; out[i] = c; }
    float km = 0.f;
    for (int i = 0; i < 8; ++i) {
      const bf16_t* kp = p.FOXQKV + (size_t)(b * SEQL + tid * 8 + i) * 1536 + 512 + h * 64;
      float ss = 0.f;
#pragma unroll
      for (int c8 = 0; c8 < 8; ++c8) {
        const u32x4 r = *(const u32x4*)(kp + c8 * 8);
        ss += bflo(r.x) * bflo(r.x) + bfhi(r.x) * bfhi(r.x) + bflo(r.y) * bflo(r.y) + bfhi(r.y) * bfhi(r.y)
            + bflo(r.z) * bflo(r.z) + bfhi(r.z) * bfhi(r.z) + bflo(r.w) * bflo(r.w) + bfhi(r.w) * bfhi(r.w);
      }
      km = fmaxf(km, ss);
    }
#pragma unroll
    for (int o = 32; o >= 1; o >>= 1) km = fmaxf(km, __shfl_xor(km, o));
    __syncthreads();
    if (lane == 0) wsum[wave] = km;
    __syncthreads();
    if (tid == 0) { float m = wsum[0]; for (int w = 1; w < 8; ++w) m = fmaxf(m, wsum[w]); ((float*)(p.ctrl + 64))[it] = sqrtf(m); }
    __syncthreads();
  }
}

__device__ void gates_halo_phase(const Params& p, int layer) {
  const int tid = tidx(), lane = tid & 63, gw = bidx() * 8 + (tid >> 6), nw = (int)gridDim.x * 8;
  for (int task = gw; task < 512 * 12; task += nw) {
    const int r = task / 12, hh = task % 12;
    const size_t t = (size_t)r * 64 + lane;
    if (hh < 8) {
      const float dt = softplusf_(p.small[t * 32 + hh] + p.ssd_dt_bias[layer * 8 + hh]);
      float inc = dt * -__expf(p.ssd_a_log[layer * 8 + hh]);
#pragma unroll
      for (int o = 1; o < 64; o <<= 1) { const float v = __shfl_up(inc, o); if (lane >= o) inc += v; }
      p.small[t * 32 + hh] = dt; p.small[t * 32 + 24 + hh] = inc;
    } else {
      const int h = hh - 8;
      const float be = sigmoidf_(p.small[t * 32 + 8 + h]);
      float inc = -__expf(p.dn_a_log[layer * 4 + h]) * softplusf_(p.small[t * 32 + 12 + h] + p.dn_dt_bias[layer * 4 + h]);
#pragma unroll
      for (int o = 1; o < 64; o <<= 1) { const float v = __shfl_up(inc, o); if (lane >= o) inc += v; }
      p.small[t * 32 + 8 + h] = be; p.small[t * 32 + 12 + h] = inc;
    }
  }
}

__device__ void conv_phase(const Params& p, int layer) {
  const int tid = tidx(), lane = tid & 63, gw = bidx() * 8 + (tid >> 6), nw = (int)gridDim.x * 8;
  for (int ww = gw; ww < 512 * 5; ww += nw) {
    const int r = ww / 5, cg = ww % 5, cc = cg * 64 + lane;
    bf16_t* base; int ld; const float* cw; float bias[8];
    if (cg < 2) {
      const int ch = cc * 8; base = p.XBC + ch; ld = 1024; cw = p.ssd_conv_w + (size_t)layer * 4 * 1024 + ch;
#pragma unroll
      for (int j = 0; j < 8; ++j) bias[j] = p.ssd_conv_b[layer * 1024 + ch + j];
    } else {
      const int ch = (cc - 128) * 8; base = p.DNQKV + ch; ld = 1536; cw = p.dn_conv_w + (size_t)layer * 4 * 1536 + ch;
#pragma unroll
      for (int j = 0; j < 8; ++j) bias[j] = 0.f;
    }
    const int wld = (cg < 2) ? 1024 : 1536;
    float w[4][8];
#pragma unroll
    for (int k = 0; k < 4; ++k) {
      const f32x4 a = *(const f32x4*)(cw + k * wld), b = *(const f32x4*)(cw + k * wld + 4);
      w[k][0] = a[0]; w[k][1] = a[1]; w[k][2] = a[2]; w[k][3] = a[3]; w[k][4] = b[0]; w[k][5] = b[1]; w[k][6] = b[2]; w[k][7] = b[3];
    }
    u32x4 h0 = {0u, 0u, 0u, 0u}, h1 = h0, h2 = h0;
    if ((r & 63) != 0) {
      const bf16_t* hp = p.halo + (size_t)r * 3 * 2560 + cc * 8;
      h0 = *(const u32x4*)hp; h1 = *(const u32x4*)(hp + 2560); h2 = *(const u32x4*)(hp + 5120);
    }
    bf16_t* rowp = base + (size_t)r * 64 * ld;
    const float qs = (cg == 2) ? 0.08838834764831845f : 1.f;
    u32x4 nxt[4];
#pragma unroll
    for (int i = 0; i < 4; ++i) nxt[i] = *(const u32x4*)(rowp + (size_t)i * ld);
    for (int i0 = 0; i0 < 64; i0 += 4) {
      u32x4 cur[4];
#pragma unroll
      for (int i = 0; i < 4; ++i) cur[i] = nxt[i];
      if (i0 + 4 < 64) {
#pragma unroll
        for (int i = 0; i < 4; ++i) nxt[i] = *(const u32x4*)(rowp + (size_t)(i0 + 4 + i) * ld);
      }
#pragma unroll
      for (int i = 0; i < 4; ++i) {
        const u32x4 c3 = cur[i];
        float a[8];
        a[0] = bias[0] + w[0][0] * bflo(h0.x) + w[1][0] * bflo(h1.x) + w[2][0] * bflo(h2.x) + w[3][0] * bflo(c3.x);
        a[1] = bias[1] + w[0][1] * bfhi(h0.x) + w[1][1] * bfhi(h1.x) + w[2][1] * bfhi(h2.x) + w[3][1] * bfhi(c3.x);
        a[2] = bias[2] + w[0][2] * bflo(h0.y) + w[1][2] * bflo(h1.y) + w[2][2] * bflo(h2.y) + w[3][2] * bflo(c3.y);
        a[3] = bias[3] + w[0][3] * bfhi(h0.y) + w[1][3] * bfhi(h1.y) + w[2][3] * bfhi(h2.y) + w[3][3] * bfhi(c3.y);
        a[4] = bias[4] + w[0][4] * bflo(h0.z) + w[1][4] * bflo(h1.z) + w[2][4] * bflo(h2.z) + w[3][4] * bflo(c3.z);
        a[5] = bias[5] + w[0][5] * bfhi(h0.z) + w[1][5] * bfhi(h1.z) + w[2][5] * bfhi(h2.z) + w[3][5] * bfhi(c3.z);
        a[6] = bias[6] + w[0][6] * bflo(h0.w) + w[1][6] * bflo(h1.w) + w[2][6] * bflo(h2.w) + w[3][6] * bflo(c3.w);
        a[7] = bias[7] + w[0][7] * bfhi(h0.w) + w[1][7] * bfhi(h1.w) + w[2][7] * bfhi(h2.w) + w[3][7] * bfhi(c3.w);
        float ss = 0.f;
#pragma unroll
        for (int j = 0; j < 8; ++j) { a[j] = siluf_(a[j]); ss += a[j] * a[j]; }
        float rn = 1.f;
        if (cg == 2 || cg == 3) {
          ss += __shfl_xor(ss, 1); ss += __shfl_xor(ss, 2); ss += __shfl_xor(ss, 4); ss += __shfl_xor(ss, 8);
          rn = rsqrtf(ss + 1e-6f) * qs;
        }
        u32x4 o; o.x = pk_bf16(a[0] * rn, a[1] * rn); o.y = pk_bf16(a[2] * rn, a[3] * rn); o.z = pk_bf16(a[4] * rn, a[5] * rn); o.w = pk_bf16(a[6] * rn, a[7] * rn);
        *(u32x4*)(rowp + (size_t)(i0 + i) * ld) = o;
        h0 = h1; h1 = h2; h2 = c3;
      }
    }
  }
}

__device__ void sg_item(const Params& p, int layer, int item, char* lds, bool st_en) {
  const int tid = tidx(), lane = tid & 63, wave = tid >> 6;
  const int g = item & 3, t0 = (item >> 2) * 128;
  bf16_t* Vt = (bf16_t*)lds;
  bf16_t* Ws = Vt + 128 * 136;
  const float* w = p.sg_w + ((size_t)(layer * 4 + g)) * 128 * 128;
  for (int i = tid; i < 128 * 32; i += NT) {
    const int t = i >> 5, s4 = (i & 31) * 4;
    f32x4 v = *(const f32x4*)(w + t * 128 + s4);
    u32x2 o; o.x = pk_bf16(s4 + 0 <= t ? v[0] : 0.f, s4 + 1 <= t ? v[1] : 0.f); o.y = pk_bf16(s4 + 2 <= t ? v[2] : 0.f, s4 + 3 <= t ? v[3] : 0.f);
    *(u32x2*)(Ws + t * 136 + s4) = o;
  }
  const float* lg = p.sg_ln_g + layer * 512; const float* lb = p.sg_ln_b + layer * 512;
  for (int tb8 = 0; tb8 < 16; tb8 += 8) {
  u32x4 rawv[8];
#pragma unroll
  for (int tt = 0; tt < 8; ++tt) rawv[tt] = *(const u32x4*)(p.SGUV + (size_t)(t0 + wave * 16 + tb8 + tt) * 1024 + 512 + lane * 8);
#pragma unroll
  for (int tt = 0; tt < 8; ++tt) {
    const int tok = wave * 16 + tb8 + tt;
    const u32x4 raw = rawv[tt];
    float x[8];
    x[0] = geluf_(bflo(raw.x)); x[1] = geluf_(bfhi(raw.x)); x[2] = geluf_(bflo(raw.y)); x[3] = geluf_(bfhi(raw.y));
    x[4] = geluf_(bflo(raw.z)); x[5] = geluf_(bfhi(raw.z)); x[6] = geluf_(bflo(raw.w)); x[7] = geluf_(bfhi(raw.w));
    float s = 0.f;
#pragma unroll
    for (int j = 0; j < 8; ++j) s += x[j];
    const float mu = wave_sum(s) * (1.f / 512.f);
    float q = 0.f;
#pragma unroll
    for (int j = 0; j < 8; ++j) { x[j] -= mu; q += x[j] * x[j]; }
    const float rstd = rsqrtf(wave_sum(q) * (1.f / 512.f) + 1e-5f);
    if ((lane >> 4) == g) {
#pragma unroll
      for (int j = 0; j < 8; ++j) {
        const int ch = lane * 8 + j, d = (lane & 15) * 8 + j;
        Vt[d * 136 + tok] = f2bf(x[j] * rstd * lg[ch] + lb[ch]);
      }
    }
  }
  }
  __syncthreads();
  const int K = ((wave * 16 + 15) / 32 + 1) * 32;
  const int tok = wave * 16 + (lane & 15);
  const float bias = p.sg_b[(size_t)(layer * 4 + g) * 128 + tok];
#pragma unroll
  for (int nt = 0; nt < 8; ++nt) {
    f32x4 acc = {0.f, 0.f, 0.f, 0.f};
    acc = mma16(Vt + nt * 16 * 136, 136, Ws + wave * 16 * 136, 136, K, acc, lane);
    const int ch = g * 128 + nt * 16 + (lane >> 4) * 4;
    bf16_t* up = p.SGUV + (size_t)(t0 + tok) * 1024 + ch;
    const u32x2 ur = *(const u32x2*)up;
    u32x2 o;
    o.x = pk_bf16(geluf_(bflo(ur.x)) * (acc[0] + bias), geluf_(bfhi(ur.x)) * (acc[1] + bias));
    o.y = pk_bf16(geluf_(bflo(ur.y)) * (acc[2] + bias), geluf_(bfhi(ur.y)) * (acc[3] + bias));
    if (st_en) *(u32x2*)up = o;
  }
  __syncthreads();
}

__device__ void fox_item(const Params& p, int layer, int item, char* lds, bool st_en) {
  const int tid = tidx(), lane = tid & 63, wave = tid >> 6;
  const int qb = item & 31, bh = item >> 5, b = bh >> 3, h = bh & 7;
  bf16_t* Ks = (bf16_t*)lds;
  bf16_t* Vt = Ks + 64 * 72;
  float* ck = (float*)(Vt + 64 * 72);
  const float LOG2E = 1.4426950408889634f;
  const float sl2 = 0.125f * LOG2E;
  const bf16_t* base = p.FOXQKV + (size_t)b * SEQL * 1536;
  const float* cb = p.cbuf + (size_t)bh * SEQL;
  const int q0 = qb * 128 + wave * 16;
  const int qi = q0 + (lane & 15);
  bf16x8 qf[2];
  qf[0] = *(const bf16x8*)(base + (size_t)qi * 1536 + h * 64 + (lane >> 4) * 8);
  qf[1] = *(const bf16x8*)(base + (size_t)qi * 1536 + h * 64 + 32 + (lane >> 4) * 8);
  const float cq = cb[qi] * LOG2E;
  f32x4 o[4];
#pragma unroll
  for (int i = 0; i < 4; ++i) o[i] = (f32x4){0.f, 0.f, 0.f, 0.f};
  float mrun = -INFINITY, lrun = 0.f;
  const int ntiles = (qb + 1) * 2;
  int jstart;
  {
    float* red = (float*)lds;
    float qs = 0.f;
#pragma unroll
    for (int i = 0; i < 2; ++i) {
      u32x4 w; __builtin_memcpy(&w, &qf[i], 16);
      qs += bflo(w.x) * bflo(w.x) + bfhi(w.x) * bfhi(w.x) + bflo(w.y) * bflo(w.y) + bfhi(w.y) * bfhi(w.y)
          + bflo(w.z) * bflo(w.z) + bfhi(w.z) * bfhi(w.z) + bflo(w.w) * bflo(w.w) + bfhi(w.w) * bfhi(w.w);
    }
    qs += __shfl_xor(qs, 16); qs += __shfl_xor(qs, 32);
#pragma unroll
    for (int o = 8; o >= 1; o >>= 1) qs = fmaxf(qs, __shfl_xor(qs, o));
    if (lane == 0) red[wave] = qs;
    __syncthreads();
    float qm = red[0];
#pragma unroll
    for (int w = 1; w < 8; ++w) qm = fmaxf(qm, red[w]);
    const float qkmax = sqrtf(qm) * ((const float*)(p.ctrl + 64))[bh] * sl2;
    const float thr = -152.f - 2.f * qkmax;
    const float cfirst = cb[qb * 128] * LOG2E;
    const bool live = (lane < ntiles) && (cfirst - cb[lane * 64 + 63] * LOG2E >= thr);
    const unsigned long long bal = __ballot(live);
    jstart = bal ? (int)__builtin_ctzll(bal) : 0;
    __syncthreads();
  }
  const int lkey = tid >> 3, lseg = (tid & 7) * 8;
  u32x4 kr = *(const u32x4*)(base + (size_t)(jstart * 64 + lkey) * 1536 + 512 + h * 64 + lseg);
  u32x4 vr = *(const u32x4*)(base + (size_t)(jstart * 64 + lkey) * 1536 + 1024 + h * 64 + lseg);
  float ckv = (tid < 64) ? cb[jstart * 64 + tid] * LOG2E : 0.f;
  for (int j = jstart; j < ntiles; ++j) {
    const int k0 = j * 64;
    __syncthreads();
    *(u32x4*)(Ks + lkey * 72 + lseg) = kr;
    {
      const int lks = lkey ^ (lseg & 56);
      Vt[(lseg + 0) * 72 + lks] = (bf16_t)(vr.x & 0xffff); Vt[(lseg + 1) * 72 + lks] = (bf16_t)(vr.x >> 16);
      Vt[(lseg + 2) * 72 + lks] = (bf16_t)(vr.y & 0xffff); Vt[(lseg + 3) * 72 + lks] = (bf16_t)(vr.y >> 16);
      Vt[(lseg + 4) * 72 + lks] = (bf16_t)(vr.z & 0xffff); Vt[(lseg + 5) * 72 + lks] = (bf16_t)(vr.z >> 16);
      Vt[(lseg + 6) * 72 + lks] = (bf16_t)(vr.w & 0xffff); Vt[(lseg + 7) * 72 + lks] = (bf16_t)(vr.w >> 16);
    }
    if (tid < 64) ck[tid] = ckv;
    if (j + 1 < ntiles) {
      kr = *(const u32x4*)(base + (size_t)(k0 + 64 + lkey) * 1536 + 512 + h * 64 + lseg);
      vr = *(const u32x4*)(base + (size_t)(k0 + 64 + lkey) * 1536 + 1024 + h * 64 + lseg);
      if (tid < 64) ckv = cb[k0 + 64 + tid] * LOG2E;
    }
    __syncthreads();
    if (k0 > q0 + 15) continue;
    f32x4 s[4];
#pragma unroll
    for (int kt = 0; kt < 4; ++kt) {
      const bf16_t* ka = Ks + (kt * 16 + (lane & 15)) * 72 + (lane >> 4) * 8;
      f32x4 a = {0.f, 0.f, 0.f, 0.f};
      a = __builtin_amdgcn_mfma_f32_16x16x32_bf16(*(const bf16x8*)ka, qf[0], a, 0, 0, 0);
      a = __builtin_amdgcn_mfma_f32_16x16x32_bf16(*(const bf16x8*)(ka + 32), qf[1], a, 0, 0, 0);
      s[kt] = a;
    }
    const bool diag = (k0 + 63 > q0);
    float mx = -INFINITY;
#pragma unroll
    for (int kt = 0; kt < 4; ++kt) {
      const f32x4 c4 = *(const f32x4*)(ck + kt * 16 + (lane >> 4) * 4);
#pragma unroll
      for (int r = 0; r < 4; ++r) {
        float v = s[kt][r] * sl2 + (cq - c4[r]);
        if (diag && (k0 + kt * 16 + (lane >> 4) * 4 + r > qi)) v = -INFINITY;
        s[kt][r] = v; mx = fmaxf(mx, v);
      }
    }
    mx = fmaxf(mx, __shfl_xor(mx, 16)); mx = fmaxf(mx, __shfl_xor(mx, 32));
    const float mnew = fmaxf(mrun, mx);
    const float alpha = __builtin_amdgcn_exp2f(mrun - mnew);
    mrun = mnew;
    float ps = 0.f;
#pragma unroll
    for (int kt = 0; kt < 4; ++kt)
#pragma unroll
      for (int r = 0; r < 4; ++r) { const float pv = __builtin_amdgcn_exp2f(s[kt][r] - mnew); s[kt][r] = pv; ps += pv; }
    lrun = lrun * alpha + ps;
#pragma unroll
    for (int i = 0; i < 4; ++i) o[i] = o[i] * alpha;
#pragma unroll
    for (int t2 = 0; t2 < 2; ++t2) {
      u32x4 pw; pw.x = pk_bf16(s[2 * t2][0], s[2 * t2][1]); pw.y = pk_bf16(s[2 * t2][2], s[2 * t2][3]);
      pw.z = pk_bf16(s[2 * t2 + 1][0], s[2 * t2 + 1][1]); pw.w = pk_bf16(s[2 * t2 + 1][2], s[2 * t2 + 1][3]);
      bf16x8 pf; __builtin_memcpy(&pf, &pw, 16);
#pragma unroll
      for (int dt = 0; dt < 4; ++dt) {
        const int vd = dt * 16 + (lane & 15), vsw = ((vd >> 3) & 7) << 3, vk = t2 * 32 + (lane >> 4) * 4;
        const bf16_t* vrow = Vt + vd * 72;
        u32x2 v0 = *(const u32x2*)(vrow + (vk ^ vsw)), v1 = *(const u32x2*)(vrow + ((vk + 16) ^ vsw));
        u32x4 vw; vw.x = v0.x; vw.y = v0.y; vw.z = v1.x; vw.w = v1.y;
        bf16x8 vf; __builtin_memcpy(&vf, &vw, 16);
        o[dt] = __builtin_amdgcn_mfma_f32_16x16x32_bf16(vf, pf, o[dt], 0, 0, 0);
      }
    }
  }
  lrun += __shfl_xor(lrun, 16); lrun += __shfl_xor(lrun, 32);
  const float inv = 1.f / lrun;
  bf16_t* op = p.FOXQKV + (size_t)(b * SEQL + qi) * 1536 + h * 64 + (lane >> 4) * 4;
#pragma unroll
  for (int dt = 0; dt < 4; ++dt) {
    u32x2 w; w.x = pk_bf16(o[dt][0] * inv, o[dt][1] * inv); w.y = pk_bf16(o[dt][2] * inv, o[dt][3] * inv);
    if (st_en) *(u32x2*)(op + dt * 16) = w;
  }
  __syncthreads();
}

__device__ void ssd_item(const Params& p, int layer, int item, char* lds, bool st_en) {
  const int tid = tidx(), lane = tid & 63, wave = tid >> 6;
  const int b = item >> 3, h = item & 7, g = h >> 2;
  bf16_t* Cs = (bf16_t*)(lds + opq(0));
  bf16_t* Bs = (bf16_t*)(lds + opq(17408));
  bf16_t* XT = (bf16_t*)(lds + opq(34816));
  bf16_t* XdT = (bf16_t*)(lds + opq(44032));
  bf16_t* Xr = (bf16_t*)(lds + opq(53248));
  bf16_t* CBm = (bf16_t*)(lds + opq(62464));
  bf16_t* Pb = (bf16_t*)(lds + opq(71680));
  float* acs = (float*)(lds + opq(89088));
  float* dtv = acs + 64;
  float* part = dtv + 64;
  const float* cw = p.ssd_conv_w + (size_t)layer * 4 * 1024;
  const float* cbias = p.ssd_conv_b + (size_t)layer * 1024;
  const float dtb = p.ssd_dt_bias[layer * 8 + h], aneg = -__expf(p.ssd_a_log[layer * 8 + h]), dsk = p.ssd_d[layer * 8 + h];
  const float* nw = p.ssd_norm_w + layer * 512 + h * 64;
  const int lt = wave >> 1, pt0 = (wave & 1) * 2;
  f32x4 st[4];
#pragma unroll
  for (int i = 0; i < 4; ++i) st[i] = (f32x4){0.f, 0.f, 0.f, 0.f};
  for (int i = tid; i < 64 * 136; i += NT) Pb[i] = 0;
  u32x4 xc, bc[2], ccv[2]; u32x2 zpre[2]; float apre = 0.f, dpre = 0.f;
  auto prefetch = [&](int step) {
    const size_t tbn = (size_t)b * SEQL + step * 64;
    const bf16_t* rp = p.XBC + tbn * 1024;
    xc = *(const u32x4*)(rp + (size_t)(tid >> 3) * 1024 + h * 64 + (tid & 7) * 8);
#pragma unroll
    for (int c = 0; c < 2; ++c) {
      const int id = tid + c * 512, s = id >> 4, col = (id & 15) * 8;
      bc[c] = *(const u32x4*)(rp + (size_t)s * 1024 + 512 + g * 128 + col);
      ccv[c] = *(const u32x4*)(rp + (size_t)s * 1024 + 768 + g * 128 + col);
    }
#pragma unroll
    for (int i = 0; i < 2; ++i)
      zpre[i] = *(const u32x2*)(p.Z + (tbn + lt * 16 + (lane & 15)) * 512 + h * 64 + (pt0 + i) * 16 + (lane >> 4) * 4);
    if (tid < 64) { apre = p.small[(tbn + tid) * 32 + 24 + h]; dpre = p.small[(tbn + tid) * 32 + h]; }
  };
  prefetch(0);
  for (int step = 0; step < 64; ++step) {
    const int l0 = step * 64;
    const size_t tb = (size_t)b * SEQL + l0;
    __syncthreads();
    if (wave == 0) { acs[lane] = apre; dtv[lane] = dpre; }
    const u32x4 xc_c = xc, bc0 = bc[0], bc1 = bc[1], cc0 = ccv[0], cc1 = ccv[1];
    const u32x2 zc0 = zpre[0], zc1 = zpre[1];
    if (step + 1 < 64) prefetch(step + 1);
    __syncthreads();
    {
      const float alast = acs[63];
      const int s = tid >> 3, col = (tid & 7) * 8;
      const float dt = dtv[s], dec = __expf(alast - acs[s]);
      *(u32x4*)(Xr + s * 72 + col) = xc_c;
      float a[8] = {bflo(xc_c.x), bfhi(xc_c.x), bflo(xc_c.y), bfhi(xc_c.y), bflo(xc_c.z), bfhi(xc_c.z), bflo(xc_c.w), bfhi(xc_c.w)};
#pragma unroll
      for (int j = 0; j < 8; ++j) { const float xd = a[j] * dt; XT[(col + j) * 72 + s] = f2bf(xd); XdT[(col + j) * 72 + s] = f2bf(xd * dec); }
#pragma unroll
      for (int c = 0; c < 2; ++c) {
        const int id = tid + c * 512, s2 = id >> 4, col2 = (id & 15) * 8;
        *(u32x4*)(Bs + s2 * 136 + col2) = c ? bc1 : bc0;
        *(u32x4*)(Cs + s2 * 136 + col2) = c ? cc1 : cc0;
      }
    }
    __syncthreads();
#pragma unroll
    for (int i = 0; i < 2; ++i) {
      const int id = wave * 2 + i, lt2 = id >> 2, st2 = id & 3;
      f32x4 a = {0.f, 0.f, 0.f, 0.f};
      a = mma16(Bs + st2 * 16 * 136, 136, Cs + lt2 * 16 * 136, 136, 128, a, lane);
      const int l = lt2 * 16 + (lane & 15), s0 = st2 * 16 + (lane >> 4) * 4;
      const float al = acs[l];
      float v[4];
#pragma unroll
      for (int r = 0; r < 4; ++r) v[r] = (s0 + r <= l) ? a[r] * __expf(al - acs[s0 + r]) : 0.f;
      u32x2 w; w.x = pk_bf16(v[0], v[1]); w.y = pk_bf16(v[2], v[3]);
      *(u32x2*)(CBm + l * 72 + s0) = w;
    }
    f32x4 yo[2];
#pragma unroll
    for (int i = 0; i < 2; ++i) {
      f32x4 a = {0.f, 0.f, 0.f, 0.f};
      yo[i] = mma16(Pb + (pt0 + i) * 16 * 136, 136, Cs + lt * 16 * 136, 136, 128, a, lane);
    }
    __syncthreads();
    {
      const int l = lt * 16 + (lane & 15);
      const float el = __expf(acs[l]);
      const size_t tok = tb + l;
      float ssq = 0.f;
#pragma unroll
      for (int i = 0; i < 2; ++i) {
        f32x4 a = {0.f, 0.f, 0.f, 0.f};
        a = mma16(XT + (pt0 + i) * 16 * 72, 72, CBm + lt * 16 * 72, 72, 64, a, lane);
        const int pp = (pt0 + i) * 16 + (lane >> 4) * 4;
        const u32x2 xr = *(const u32x2*)(Xr + l * 72 + pp);
        bf16_t* zp = p.Z + tok * 512 + h * 64 + pp;
        const u32x2 zr = i ? zc1 : zc0;
        const f32x4 nv = *(const f32x4*)(nw + pp);
        float y[4];
        y[0] = (a[0] + yo[i][0] * el + dsk * bflo(xr.x)) * siluf_(bflo(zr.x));
        y[1] = (a[1] + yo[i][1] * el + dsk * bfhi(xr.x)) * siluf_(bfhi(zr.x));
        y[2] = (a[2] + yo[i][2] * el + dsk * bflo(xr.y)) * siluf_(bflo(zr.y));
        y[3] = (a[3] + yo[i][3] * el + dsk * bfhi(xr.y)) * siluf_(bfhi(zr.y));
        ssq += (y[0] * y[0] + y[1] * y[1]) + (y[2] * y[2] + y[3] * y[3]);
        u32x2 w; w.x = pk_bf16(y[0] * nv[0], y[1] * nv[1]); w.y = pk_bf16(y[2] * nv[2], y[3] * nv[3]);
        if (st_en) *(u32x2*)zp = w;
      }
      ssq += __shfl_xor(ssq, 16); ssq += __shfl_xor(ssq, 32);
      if (lane < 16) part[(wave & 1) * 64 + l] = ssq;
    }
    {
      const float ea = __expf(acs[63]);
      const int n = wave * 16 + (lane & 15);
      bf16x8 bfr[2];
#pragma unroll
      for (int ks = 0; ks < 2; ++ks) {
        u32x4 w;
        const bf16_t* bp = Bs + (ks * 32 + (lane >> 4) * 8) * 136 + n;
        w.x = (unsigned)bp[0] | ((unsigned)bp[136] << 16); w.y = (unsigned)bp[2 * 136] | ((unsigned)bp[3 * 136] << 16);
        w.z = (unsigned)bp[4 * 136] | ((unsigned)bp[5 * 136] << 16); w.w = (unsigned)bp[6 * 136] | ((unsigned)bp[7 * 136] << 16);
        __builtin_memcpy(&bfr[ks], &w, 16);
      }
#pragma unroll
      for (int i = 0; i < 4; ++i) {
        f32x4 a = st[i] * ea;
        const bf16_t* ap = XdT + (i * 16 + (lane & 15)) * 72 + (lane >> 4) * 8;
        a = __builtin_amdgcn_mfma_f32_16x16x32_bf16(*(const bf16x8*)ap, bfr[0], a, 0, 0, 0);
        a = __builtin_amdgcn_mfma_f32_16x16x32_bf16(*(const bf16x8*)(ap + 32), bfr[1], a, 0, 0, 0);
        st[i] = a;
#pragma unroll
        for (int r = 0; r < 4; ++r) Pb[(i * 16 + (lane >> 4) * 4 + r) * 136 + n] = f2bf(a[r]);
      }
    }
    __syncthreads();
    if (tid < 64 && st_en) p.ssqp[(size_t)h * MTOK + tb + tid] = part[tid] + part[64 + tid];
  }
  __syncthreads();
}

__device__ __forceinline__ bf16_t* dn_Wg(const Params& p) { return (bf16_t*)p.hf; }
__device__ __forceinline__ float* dn_Ug(const Params& p) { return (float*)((char*)p.hf + ((size_t)32 << 20)); }
__device__ __forceinline__ bf16_t* dn_QKg(const Params& p) { return (bf16_t*)((char*)p.hf + ((size_t)96 << 20)); }

__device__ void dn_prep_item(const Params& p, int layer, int item, char* lds) {
  const int tid = tidx(), lane = tid & 63, wave = tid >> 6;
  const int step = item & 63, bh = item >> 6, b = bh >> 2, h = bh & 3;
  bf16_t* Kn = (bf16_t*)(lds + opq(0));
  bf16_t* Qn = (bf16_t*)(lds + opq(17408));
  bf16_t* Wm = (bf16_t*)(lds + opq(34816));
  bf16_t* QK = (bf16_t*)(lds + opq(52224));
  float* At = (float*)(lds + opq(61440));
  float* VU = (float*)(lds + opq(79872));
  float* gcs = (float*)(lds + opq(148480));
  float* bet = gcs + 64;
  const size_t tb = (size_t)b * SEQL + step * 64;
  __syncthreads();
  if (wave == 0) { gcs[lane] = p.small[(tb + lane) * 32 + 12 + h]; bet[lane] = p.small[(tb + lane) * 32 + 8 + h]; }
  u32x4 qv[2], kv[2], vv[2];
  {
    const bf16_t* rp = p.DNQKV + tb * 1536 + h * 128;
#pragma unroll
    for (int c = 0; c < 2; ++c) {
      const int id = tid + c * 512, s = id >> 4, dd = (id & 15) * 8;
      qv[c] = *(const u32x4*)(rp + (size_t)s * 1536 + dd);
      kv[c] = *(const u32x4*)(rp + (size_t)s * 1536 + 512 + dd);
      vv[c] = *(const u32x4*)(rp + (size_t)s * 1536 + 1024 + dd);
    }
  }
  __syncthreads();
#pragma unroll
  for (int c = 0; c < 2; ++c) {
    const int id = tid + c * 512, s = id >> 4, dd = (id & 15) * 8;
    *(u32x4*)(Qn + s * 136 + dd) = qv[c];
    *(u32x4*)(Kn + s * 136 + dd) = kv[c];
    const float be = bet[s];
    f32x4 v0 = {bflo(vv[c].x) * be, bfhi(vv[c].x) * be, bflo(vv[c].y) * be, bfhi(vv[c].y) * be};
    f32x4 v1 = {bflo(vv[c].z) * be, bfhi(vv[c].z) * be, bflo(vv[c].w) * be, bfhi(vv[c].w) * be};
    *(f32x4*)(VU + s * 132 + dd) = v0; *(f32x4*)(VU + s * 132 + dd + 4) = v1;
  }
  __syncthreads();
#pragma unroll
  for (int t = 0; t < 2; ++t) {
    const int id = wave * 2 + t, it = id >> 2, jt = id & 3;
    const int i = it * 16 + (lane & 15), j0 = jt * 16 + (lane >> 4) * 4;
    const float gi = gcs[i], bi = bet[i];
    f32x4 a = {0.f, 0.f, 0.f, 0.f};
    a = mma16(Kn + jt * 16 * 136, 136, Kn + it * 16 * 136, 136, 128, a, lane);
#pragma unroll
    for (int r = 0; r < 4; ++r) At[(j0 + r) * 64 + i] = (j0 + r < i) ? bi * a[r] * __expf(gi - gcs[j0 + r]) : 0.f;
    f32x4 q = {0.f, 0.f, 0.f, 0.f};
    q = mma16(Kn + jt * 16 * 136, 136, Qn + it * 16 * 136, 136, 128, q, lane);
    float qq[4];
#pragma unroll
    for (int r = 0; r < 4; ++r) qq[r] = (j0 + r <= i) ? q[r] * __expf(gi - gcs[j0 + r]) : 0.f;
    u32x2 w; w.x = pk_bf16(qq[0], qq[1]); w.y = pk_bf16(qq[2], qq[3]);
    *(u32x2*)(QK + i * 72 + j0) = w;
  }
  __syncthreads();
  if (tid < 256) {
    float xs[64];
    if (tid < 128) {
#pragma unroll
      for (int s = 0; s < 64; ++s) xs[s] = bf2f(Kn[s * 136 + tid]) * bet[s] * __expf(gcs[s]);
    } else {
#pragma unroll
      for (int s = 0; s < 64; ++s) xs[s] = VU[s * 132 + (tid - 128)];
    }
#pragma unroll
    for (int j = 0; j < 63; ++j) {
      const float xj = xs[j];
#pragma unroll
      for (int i = j + 1; i < 64; ++i) xs[i] -= At[j * 64 + i] * xj;
      if ((j & 3) == 3) asm volatile("" ::: "memory");
    }
    if (tid < 128) {
#pragma unroll
      for (int s = 0; s < 64; ++s) Wm[s * 136 + tid] = f2bf(xs[s]);
    } else {
#pragma unroll
      for (int s = 0; s < 64; ++s) VU[s * 132 + (tid - 128)] = xs[s];
    }
  }
  __syncthreads();
  {
    bf16_t* Wg = dn_Wg(p) + tb * 512 + h * 128;
    float* Ug = dn_Ug(p) + tb * 512 + h * 128;
    bf16_t* QKg = dn_QKg(p) + ((tb >> 6) * 4 + h) * 4096;
#pragma unroll
    for (int c = 0; c < 2; ++c) {
      const int id = tid + c * 512, s = id >> 4, dd = (id & 15) * 8;
      *(u32x4*)(Wg + (size_t)s * 512 + dd) = *(const u32x4*)(Wm + s * 136 + dd);
    }
#pragma unroll
    for (int c = 0; c < 4; ++c) {
      const int id = tid + c * 512, s = id >> 5, e4 = (id & 31) * 4;
      *(f32x4*)(Ug + (size_t)s * 512 + e4) = *(const f32x4*)(VU + s * 132 + e4);
    }
    *(u32x4*)(QKg + (tid >> 3) * 64 + (tid & 7) * 8) = *(const u32x4*)(QK + (tid >> 3) * 72 + (tid & 7) * 8);
  }
}

__device__ void dn_scan_item(const Params& p, int layer, int item, char* lds, bool st_en) {
  const int tid = tidx(), lane = tid & 63, wave = tid >> 6;
  const int b = item >> 2, h = item & 3;
  bf16_t* Kn = (bf16_t*)(lds + opq(0));
  bf16_t* Qn = (bf16_t*)(lds + opq(17408));
  bf16_t* Wm = (bf16_t*)(lds + opq(34816));
  bf16_t* QK = (bf16_t*)(lds + opq(52224));
  bf16_t* VnT = (bf16_t*)(lds + opq(61440));
  float* VU = (float*)(lds + opq(79872));
  bf16_t* ST = (bf16_t*)(lds + opq(113664));
  float* gcs = (float*)(lds + opq(148480));
  float* Of = (float*)Qn;
  const float* nw = p.dn_norm_w + layer * 128;
  f32x4 S[8];
#pragma unroll
  for (int i = 0; i < 8; ++i) S[i] = (f32x4){0.f, 0.f, 0.f, 0.f};
  for (int i = tid; i < 128 * 136; i += NT) ST[i] = 0;
  u32x4 wv[2], qv[2], kv[2], qkv; f32x4 uv[4]; float gv = 0.f; unsigned gpre[8];
  auto prefetch = [&](int step) {
    const size_t tb = (size_t)b * SEQL + step * 64;
    const bf16_t* rp = p.DNQKV + tb * 1536 + h * 128;
    const bf16_t* Wg = dn_Wg(p) + tb * 512 + h * 128;
    const float* Ug = dn_Ug(p) + tb * 512 + h * 128;
    const bf16_t* QKg = dn_QKg(p) + ((tb >> 6) * 4 + h) * 4096;
#pragma unroll
    for (int c = 0; c < 2; ++c) {
      const int id = tid + c * 512, s = id >> 4, dd = (id & 15) * 8;
      qv[c] = *(const u32x4*)(rp + (size_t)s * 1536 + dd);
      kv[c] = *(const u32x4*)(rp + (size_t)s * 1536 + 512 + dd);
      wv[c] = *(const u32x4*)(Wg + (size_t)s * 512 + dd);
    }
#pragma unroll
    for (int c = 0; c < 4; ++c) {
      const int id = tid + c * 512, s = id >> 5, e4 = (id & 31) * 4;
      uv[c] = *(const f32x4*)(Ug + (size_t)s * 512 + e4);
    }
    qkv = *(const u32x4*)(QKg + (tid >> 3) * 64 + (tid & 7) * 8);
    if (tid < 64) gv = p.small[(tb + tid) * 32 + 12 + h];
#pragma unroll
    for (int tt = 0; tt < 8; ++tt) gpre[tt] = *(const unsigned*)(p.DNG + (tb + wave * 8 + tt) * 512 + h * 128 + lane * 2);
  };
  prefetch(0);
  for (int step = 0; step < 64; ++step) {
    const size_t tb = (size_t)b * SEQL + step * 64;
    __syncthreads();
#pragma unroll
    for (int c = 0; c < 2; ++c) {
      const int id = tid + c * 512, s = id >> 4, dd = (id & 15) * 8;
      *(u32x4*)(Qn + s * 136 + dd) = qv[c];
      *(u32x4*)(Kn + s * 136 + dd) = kv[c];
      *(u32x4*)(Wm + s * 136 + dd) = wv[c];
    }
#pragma unroll
    for (int c = 0; c < 4; ++c) {
      const int id = tid + c * 512, s = id >> 5, e4 = (id & 31) * 4;
      *(f32x4*)(VU + s * 132 + e4) = uv[c];
    }
    *(u32x4*)(QK + (tid >> 3) * 72 + (tid & 7) * 8) = qkv;
    if (tid < 64) gcs[tid] = gv;
    unsigned gcur[8];
#pragma unroll
    for (int tt = 0; tt < 8; ++tt) gcur[tt] = gpre[tt];
    if (step + 1 < 64) prefetch(step + 1);
    __syncthreads();
    f32x4 o1[4];
    {
      const int stl = wave >> 1;
#pragma unroll
      for (int i = 0; i < 4; ++i) {
        const int et = (wave & 1) * 4 + i;
        f32x4 a = {0.f, 0.f, 0.f, 0.f};
        a = mma16(Wm + stl * 16 * 136, 136, ST + et * 16 * 136, 136, 128, a, lane);
        const int s0 = stl * 16 + (lane >> 4) * 4, e = et * 16 + (lane & 15);
        float vn[4];
#pragma unroll
        for (int r = 0; r < 4; ++r) vn[r] = VU[(s0 + r) * 132 + e] - a[r];
        u32x2 w; w.x = pk_bf16(vn[0], vn[1]); w.y = pk_bf16(vn[2], vn[3]);
        *(u32x2*)(VnT + e * 72 + s0) = w;
        f32x4 q = {0.f, 0.f, 0.f, 0.f};
        q = mma16(ST + et * 16 * 136, 136, Qn + stl * 16 * 136, 136, 128, q, lane);
        const float eg = __expf(gcs[stl * 16 + (lane & 15)]);
        o1[i] = q * eg;
      }
    }
    __syncthreads();
    {
      const int stl = wave >> 1;
#pragma unroll
      for (int i = 0; i < 4; ++i) {
        const int et = (wave & 1) * 4 + i;
        f32x4 a = mma16(VnT + et * 16 * 72, 72, QK + stl * 16 * 72, 72, 64, o1[i], lane);
        const int s = stl * 16 + (lane & 15), e0 = et * 16 + (lane >> 4) * 4;
        *(f32x4*)(Of + s * 132 + e0) = a;
      }
      const float gl = gcs[63], egl = __expf(gl);
      bf16x8 kf[2];
#pragma unroll
      for (int ks = 0; ks < 2; ++ks) {
        const int d = wave * 16 + (lane & 15), s0 = ks * 32 + (lane >> 4) * 8;
        float kk[8];
#pragma unroll
        for (int j = 0; j < 8; ++j) kk[j] = bf2f(Kn[(s0 + j) * 136 + d]) * __expf(gl - gcs[s0 + j]);
        u32x4 w; w.x = pk_bf16(kk[0], kk[1]); w.y = pk_bf16(kk[2], kk[3]); w.z = pk_bf16(kk[4], kk[5]); w.w = pk_bf16(kk[6], kk[7]);
        __builtin_memcpy(&kf[ks], &w, 16);
      }
#pragma unroll
      for (int et = 0; et < 8; ++et) {
        f32x4 a = S[et] * egl;
        const bf16_t* vp = VnT + (et * 16 + (lane & 15)) * 72 + (lane >> 4) * 8;
        a = __builtin_amdgcn_mfma_f32_16x16x32_bf16(kf[0], *(const bf16x8*)vp, a, 0, 0, 0);
        a = __builtin_amdgcn_mfma_f32_16x16x32_bf16(kf[1], *(const bf16x8*)(vp + 32), a, 0, 0, 0);
        S[et] = a;
      }
    }
    __syncthreads();
#pragma unroll
    for (int et = 0; et < 8; ++et) {
      u32x2 w; w.x = pk_bf16(S[et][0], S[et][1]); w.y = pk_bf16(S[et][2], S[et][3]);
      *(u32x2*)(ST + (et * 16 + (lane & 15)) * 136 + wave * 16 + (lane >> 4) * 4) = w;
    }
#pragma unroll
    for (int tt = 0; tt < 8; ++tt) {
      const int s = wave * 8 + tt;
      const float o0 = Of[s * 132 + lane * 2], o1v = Of[s * 132 + lane * 2 + 1];
      const float ss = wave_sum(o0 * o0 + o1v * o1v);
      const float rn = rsqrtf(ss * (1.f / 128.f) + 1e-6f);
      const unsigned gr = gcur[tt];
      const float y0 = o0 * rn * nw[lane * 2] * siluf_(bflo(gr)), y1 = o1v * rn * nw[lane * 2 + 1] * siluf_(bfhi(gr));
      if (st_en) *(unsigned*)(p.DNG + (tb + s) * 512 + h * 128 + lane * 2) = pk_bf16(y0, y1);
    }
  }
  __syncthreads();
}

__device__ void mixer_phase1(const Params& p, int layer, char* lds) {
  for (int it = bidx(); it < 2048; it += (int)gridDim.x) dn_prep_item(p, layer, it, lds);
  __syncthreads();
}
__device__ void mixer_phase2(const Params& p, int layer, char* lds, int* s_item) {
  constexpr int N_SEQ = 96, N_FOX = 2048, N_SG = 1024, TOTAL = N_SEQ + N_FOX + N_SG;
  unsigned* ctr = p.ctrl + layer;
  for (;;) {
    if (tidx() == 0) *s_item = (int)atomicAdd(ctr, 1u);
    __syncthreads();
    const int it = *s_item;
    __syncthreads();
    if (it >= TOTAL) break;
    if (it < 32) dn_scan_item(p, layer, it, lds, true);
    else if (it < N_SEQ) ssd_item(p, layer, it - 32, lds, true);
    else if (it < N_SEQ + N_FOX) { const int u = it - N_SEQ; fox_item(p, layer, ((u & 63) << 5) | (31 - (u >> 6)), lds, true); }
    else sg_item(p, layer, it - N_SEQ - N_FOX, lds, true);
  }
}

__device__ void merge_phase(const Params& p, int layer, PG8_LAS unsigned char* lds3) {
  const int lane = tidx() & 63, wave = tidx() >> 6, wm = wave >> 2, wn = wave & 3;
  bf16_t* merged = p.XBC;
  for (int t = bidx(); t < 256 * 4; t += gridDim.x) {
    const int mt = t >> 2, nt = t & 3, m0 = mt * 128, n0 = nt * 256;
    f32x16 mg[2][2];
    zero_acc<2, 2>(mg);
#pragma unroll 1
    for (int br = 0; br < 4; ++br) {
      unsigned gp[2][2][8];
      {
        f32x16 acc[2][2];
        zero_acc<2, 2>(acc);
        gemm_mainloop_dma<2, 2, true>(p.hb + (size_t)m0 * DM, DM, p.WinT + (size_t)(NPROJ + br * 1024 + n0) * DM, DM, DM, lds3, acc);
        const float* gb = p.gate_b + (size_t)(layer * 4 + br) * 1024 + n0;
#pragma unroll
        for (int ni = 0; ni < 2; ++ni)
#pragma unroll
          for (int q = 0; q < 4; ++q) {
            const f32x4 bv = *(const f32x4*)(gb + ni * 128 + wn * 32 + q * 8 + (lane >> 5) * 4);
#pragma unroll
            for (int mi = 0; mi < 2; ++mi) {
              gp[ni][mi][q * 2 + 0] = pk_bf16(sigmoidf_(acc[mi][ni][q * 4 + 0] + bv[0]), sigmoidf_(acc[mi][ni][q * 4 + 1] + bv[1]));
              gp[ni][mi][q * 2 + 1] = pk_bf16(sigmoidf_(acc[mi][ni][q * 4 + 2] + bv[2]), sigmoidf_(acc[mi][ni][q * 4 + 3] + bv[3]));
            }
          }
      }
      const bf16_t* ya; int lda;
      if (br == 0) { ya = p.Z; lda = 512; }
      else if (br == 1) { ya = p.DNG; lda = 512; }
      else if (br == 2) { ya = p.SGUV; lda = 1024; }
      else { ya = p.FOXQKV; lda = 1536; }
      float rs[2] = {1.f, 1.f};
      if (br == 0) {
#pragma unroll
        for (int mi = 0; mi < 2; ++mi) {
          const int m = m0 + wm * 64 + mi * 32 + (lane & 31);
          float ss = 0.f;
#pragma unroll
          for (int hh = 0; hh < 8; ++hh) ss += p.ssqp[(size_t)hh * MTOK + m];
          rs[mi] = rsqrtf(ss * (1.f / 512.f) + 1e-6f);
        }
      }
#pragma unroll
      for (int half = 0; half < 2; ++half) {
        f32x16 acc[2][1];
        zero_acc<2, 1>(acc);
        gemm_mainloop_dma128<2, 1>(ya + (size_t)m0 * lda, lda, p.WbT + ((size_t)br * 1024 + n0 + half * 128) * 512, 512, 512, lds3, acc);
#pragma unroll
        for (int mi = 0; mi < 2; ++mi)
#pragma unroll
          for (int q = 0; q < 4; ++q) {
            mg[half][mi][q * 4 + 0] += bflo(gp[half][mi][q * 2 + 0]) * acc[mi][0][q * 4 + 0] * rs[mi];
            mg[half][mi][q * 4 + 1] += bfhi(gp[half][mi][q * 2 + 0]) * acc[mi][0][q * 4 + 1] * rs[mi];
            mg[half][mi][q * 4 + 2] += bflo(gp[half][mi][q * 2 + 1]) * acc[mi][0][q * 4 + 2] * rs[mi];
            mg[half][mi][q * 4 + 3] += bfhi(gp[half][mi][q * 2 + 1]) * acc[mi][0][q * 4 + 3] * rs[mi];
          }
      }
    }
#pragma unroll
    for (int half = 0; half < 2; ++half)
#pragma unroll
      for (int mi = 0; mi < 2; ++mi) {
        const int m = m0 + wm * 64 + mi * 32 + (lane & 31);
#pragma unroll
        for (int q = 0; q < 4; ++q) {
          const int n = n0 + half * 128 + wn * 32 + q * 8 + (lane >> 5) * 4;
          u32x2 w; w.x = pk_bf16(mg[half][mi][q * 4 + 0], mg[half][mi][q * 4 + 1]); w.y = pk_bf16(mg[half][mi][q * 4 + 2], mg[half][mi][q * 4 + 3]);
          *(u32x2*)(merged + (size_t)m * DM + n) = w;
        }
      }
  }
}

__device__ void resid_gemm_phase(const Params& p, const bf16_t* A, int K, const bf16_t* Bt, char* lds) {
  const int lane = tidx() & 63, wave = tidx() >> 6, wm = wave >> 2, wn = wave & 3;
  for (int t = bidx(); t < 128 * 4; t += gridDim.x) {
    const int mt = t >> 2, nt = t & 3;
    f32x16 acc[4][2];
    zero_acc<4, 2>(acc);
    gemm_mainloop<4, 2>(A + (size_t)mt * 256 * K, K, Bt + (size_t)nt * 256 * K, K, K, lds, acc);
#pragma unroll
    for (int mi = 0; mi < 4; ++mi) {
      const int m = mt * 256 + wm * 128 + mi * 32 + (lane & 31);
#pragma unroll
      for (int ni = 0; ni < 2; ++ni)
#pragma unroll
        for (int q = 0; q < 4; ++q) {
          const int n = nt * 256 + wn * 64 + ni * 32 + q * 8 + (lane >> 5) * 4;
          float* hp = p.hf + (size_t)m * DM + n;
          f32x4 v = *(const f32x4*)hp;
          v[0] = ALPHA * v[0] + acc[mi][ni][q * 4 + 0]; v[1] = ALPHA * v[1] + acc[mi][ni][q * 4 + 1];
          v[2] = ALPHA * v[2] + acc[mi][ni][q * 4 + 2]; v[3] = ALPHA * v[3] + acc[mi][ni][q * 4 + 3];
          *(f32x4*)hp = v;
        }
      asm volatile("" ::: "memory");
    }
  }
}

__device__ void up_phase(const Params& p, char* lds) {
  const int lane = tidx() & 63, wave = tidx() >> 6, wm = wave >> 2, wn = wave & 3;
  for (int t = bidx(); t < 128 * 16; t += gridDim.x) {
    const int mt = t >> 4, nt = t & 15;
    f32x16 acc[4][2];
    zero_acc<4, 2>(acc);
    gemm_mainloop<4, 2>(p.hb + (size_t)mt * 256 * DM, DM, p.WupT + (size_t)nt * 256 * DM, DM, DM, lds, acc);
#pragma unroll
    for (int mi = 0; mi < 4; ++mi) {
      const int m = mt * 256 + wm * 128 + mi * 32 + (lane & 31);
#pragma unroll
      for (int ni = 0; ni < 2; ++ni)
#pragma unroll
        for (int q = 0; q < 4; ++q) {
          const int n = nt * 256 + wn * 64 + ni * 32 + q * 8 + (lane >> 5) * 4;
          float r0 = fmaxf(acc[mi][ni][q * 4 + 0], 0.f), r1 = fmaxf(acc[mi][ni][q * 4 + 1], 0.f), r2 = fmaxf(acc[mi][ni][q * 4 + 2], 0.f), r3 = fmaxf(acc[mi][ni][q * 4 + 3], 0.f);
          u32x2 w; w.x = pk_bf16(r0 * r0, r1 * r1); w.y = pk_bf16(r2 * r2, r3 * r3);
          *(u32x2*)(p.U + (size_t)m * DFF + n) = w;
        }
    }
  }
}


#ifndef DBG_STOP
#define DBG_STOP 0
#endif
#ifndef DBG_QMASK
#define DBG_QMASK 1
#endif
__device__ void dbg_dump(const Params& p, int which) {
  const int tid = tidx();
  for (int m = bidx(); m < MTOK; m += (int)gridDim.x) {
    for (int n = tid; n < 1024; n += NT) {
      float v = 0.f;
      if (which == 1) {
        v = bf2f(p.Z[(size_t)m * 512 + (n & 511)]) + bf2f(p.XBC[(size_t)m * 1024 + n]) + bf2f(p.DNQKV[(size_t)m * 1536 + n]) + bf2f(p.DNQKV[(size_t)m * 1536 + 512 + n])
          + bf2f(p.DNG[(size_t)m * 512 + (n & 511)]) + bf2f(p.SGUV[(size_t)m * 1024 + n]) + bf2f(p.FOXQKV[(size_t)m * 1536 + n]) + bf2f(p.FOXQKV[(size_t)m * 1536 + 512 + n]) + p.small[(size_t)m * 32 + (n & 31)];
      } else if (which == 2) {
        v = p.cbuf[(size_t)(m >> 12) * 8 * SEQL + (size_t)(n & 7) * SEQL + (m & 4095)];
      } else if (which == 3) {
        const int q = n >> 8, c = n & 255;
        if (!((DBG_QMASK >> q) & 1)) { p.hf[(size_t)m * DM + n] = 1.f; continue; }
        if (q == 0) v = bf2f(p.Z[(size_t)m * 512 + c]) + bf2f(p.Z[(size_t)m * 512 + 256 + c]) + p.ssqp[(size_t)(c & 7) * MTOK + m];
        else if (q == 1) v = bf2f(p.DNG[(size_t)m * 512 + c]) + bf2f(p.DNG[(size_t)m * 512 + 256 + c]);
        else if (q == 2) v = bf2f(p.SGUV[(size_t)m * 1024 + c]) + bf2f(p.SGUV[(size_t)m * 1024 + 256 + c]);
        else v = bf2f(p.FOXQKV[(size_t)m * 1536 + c]) + bf2f(p.FOXQKV[(size_t)m * 1536 + 256 + c]);
      } else if (which == 4) {
        v = bf2f(p.XBC[(size_t)m * 1024 + n]);
      } else if (which == 7) {
        v = bf2f(p.U[(size_t)m * 4096 + n]) + bf2f(p.U[(size_t)m * 4096 + 1024 + n]) + bf2f(p.U[(size_t)m * 4096 + 2048 + n]) + bf2f(p.U[(size_t)m * 4096 + 3072 + n]);
      }
      p.hf[(size_t)m * DM + n] = v;
    }
  }
}
#define LAS __attribute__((address_space(3)))
#define XB_TMO      128
#define XB_XCNT(j)  (256  + 64 * (j))
#define XB_XSUB(j)  (1280 + 64 * (j))
#define XB_XGEN(j)  (2304 + 64 * (j))
#define XB_TOP      3328
#define XB_TOPGEN   3392
#define XCD_BAR_WORDS 3456
#define XB_SPIN_CAP (1u << 18)

__device__ __forceinline__ unsigned xb_ld(unsigned* p)              { return __hip_atomic_load(p, __ATOMIC_RELAXED, __HIP_MEMORY_SCOPE_AGENT); }
__device__ __forceinline__ unsigned xb_add(unsigned* p, unsigned v) { return __hip_atomic_fetch_add(p, v, __ATOMIC_RELAXED, __HIP_MEMORY_SCOPE_AGENT); }
__device__ __forceinline__ unsigned xb_xcc_id() { return (unsigned)__builtin_amdgcn_s_getreg((3 << 11) | 20) & 0xFu; }
#define XB_SPIN(cond, bar) do { unsigned _sp = 0; while (cond) { __builtin_amdgcn_s_sleep(1); \
    if ((++_sp & 255u) == 0u) { if (xb_ld(&(bar)[XB_TMO])) break; if (_sp > XB_SPIN_CAP) { atomicAdd(&(bar)[XB_TMO], 1u); break; } } } } while (0)

struct XcdBarrier {
    unsigned* bar; unsigned x;
    volatile LAS unsigned* st;
};

__device__ __forceinline__ XcdBarrier xcd_barrier_post(unsigned* bar, volatile LAS unsigned* st) {
    XcdBarrier b; b.bar = bar; b.x = xb_xcc_id(); b.st = st;
    if (threadIdx.x == 0) (void)xb_add(&bar[XB_XCNT(b.x)], 1u);
    return b;
}
__device__ __forceinline__ void xcd_barrier_complete(unsigned* bar, unsigned x, unsigned& nloc, unsigned& nx) {
    const unsigned G = gridDim.x * gridDim.y * gridDim.z;
    unsigned sum, cnt, mine, sp = 0u;
    for (;;) {
        sum = 0u; cnt = 0u; mine = 0u;
#pragma unroll
        for (unsigned j = 0; j < 16; ++j) { const unsigned c = xb_ld(&bar[XB_XCNT(j)]); sum += c; cnt += (c > 0u) ? 1u : 0u; mine = (j == x) ? c : mine; }
        if (sum == G) break;
        __builtin_amdgcn_s_sleep(1);
        if ((++sp & 255u) == 0u) { if (xb_ld(&bar[XB_TMO])) break; if (sp > XB_SPIN_CAP) { atomicAdd(&bar[XB_TMO], 1u); break; } }
    }
    nloc = mine > 0u ? mine : 1u; nx = cnt > 0u ? cnt : 1u;
}

__device__ __forceinline__ void xcd_barrier(const XcdBarrier& b) {
    asm volatile("s_waitcnt vmcnt(0)" ::: "memory");
    __syncthreads();
    if (threadIdx.x == 0) {
        unsigned* bar = b.bar;
        __builtin_amdgcn_s_waitcnt(0);
        unsigned nloc = b.st[0], nx = b.st[1];
        if (nloc == 0u) { xcd_barrier_complete(bar, b.x, nloc, nx); b.st[0] = nloc; b.st[1] = nx; }
        const unsigned old = xb_add(&bar[XB_XSUB(b.x)], 1u);
        const unsigned gen = old / nloc;
        if (old + 1u == (gen + 1u) * nloc) {
            __builtin_amdgcn_fence(__ATOMIC_RELEASE, "agent");
            asm volatile("s_waitcnt vmcnt(0)" ::: "memory");
            const unsigned og = xb_add(&bar[XB_TOP], 1u);
            const unsigned tg = og / nx;
            if (og + 1u == (tg + 1u) * nx) xb_add(&bar[XB_TOPGEN], 1u);
            else XB_SPIN(xb_ld(&bar[XB_TOPGEN]) == tg, bar);
            __builtin_amdgcn_fence(__ATOMIC_ACQUIRE, "agent");
            xb_add(&bar[XB_XGEN(b.x)], 1u);
            asm volatile("s_waitcnt vmcnt(0)" ::: "memory");
        } else {
            XB_SPIN(xb_ld(&bar[XB_XGEN(b.x)]) == gen, bar);
            __builtin_amdgcn_fence(__ATOMIC_ACQUIRE, "agent");
            asm volatile("s_waitcnt vmcnt(0)" ::: "memory");
        }
    }
    __syncthreads();
}

#define CG_SYNC() do { asm volatile("s_waitcnt vmcnt(0) lgkmcnt(0)" ::: "memory"); grid.sync(); } while (0)
#define GRID_SYNC() xcd_barrier(xb)
__global__ void __launch_bounds__(NT) hybrid_fwd(Params p) {
  extern __shared__ __attribute__((aligned(16))) char smem[];
  cg::grid_group grid = cg::this_grid();
  int* s_item = (int*)smem;
  char* lds = smem + 64;
  PG8_LAS unsigned char* lds3 = (PG8_LAS unsigned char*)smem + 1024;
  volatile LAS unsigned* xst = (volatile LAS unsigned*)((LAS unsigned char*)smem + 16);
  if (threadIdx.x == 0) { xst[0] = 0u; xst[1] = 0u; }
  __syncthreads();
  const XcdBarrier xb = xcd_barrier_post(p.ctrl, xst);
  ln_phase(p.x, nullptr, p.hb, p.ln_in_g, p.ln_in_b);
  convert_weights(p, 0, lds);
  CG_SYNC();
  for (int layer = 0; layer < 2; ++layer) {
    { EpiProj E; E.p = p; pg8_phase(p.hb, p.WinT, NPROJ, DM, E, lds3); }
    GRID_SYNC();
    if (DBG_STOP == 1) { dbg_dump(p, 1); return; }
    conv_phase(p, layer);
    gates_halo_phase(p, layer);
    foxc_phase(p, layer, lds);
    GRID_SYNC();
    if (DBG_STOP == 2) { dbg_dump(p, 2); return; }
    mixer_phase1(p, layer, lds);
    GRID_SYNC();
    mixer_phase2(p, layer, lds, s_item);
    GRID_SYNC();
    if (DBG_STOP == 3) { dbg_dump(p, 3); return; }
    merge_phase(p, layer, lds3);
    GRID_SYNC();
    if (DBG_STOP == 4) { dbg_dump(p, 4); return; }
    { EpiResid E; E.hf = p.hf; E.hb = p.hb; pg8_phase(p.XBC, p.WoT, DM, DM, E, lds3); }
    GRID_SYNC();
    if (DBG_STOP == 5) return;
    ln_phase(p.hf, nullptr, p.hb, p.ln1_g + layer * DM, p.ln1_b + layer * DM);
    GRID_SYNC();
    if (DBG_STOP == 6) return;
    { EpiUp E; E.U = p.U; pg8_phase(p.hb, p.WupT, DFF, DM, E, lds3); }
    GRID_SYNC();
    if (DBG_STOP == 7) { dbg_dump(p, 7); return; }
    { EpiResid E; E.hf = p.hf; E.hb = p.hb; pg8_phase(p.U, p.WdnT, DM, DFF, E, lds3); }
    GRID_SYNC();
    if (DBG_STOP == 8) return;
    ln_phase(p.hf, layer == 1 ? p.hf : nullptr, p.hb, p.ln2_g + layer * DM, p.ln2_b + layer * DM);
    if (DBG_STOP == 9) return;
    if (layer == 0) { convert_weights(p, 1, lds); GRID_SYNC(); }
  }
}

extern "C" void kernel_launch(void* const* d_in, const int* in_sizes, int n_in, void* d_out, int out_size, void* d_ws, size_t ws_size, hipStream_t stream) {
  (void)in_sizes; (void)n_in; (void)out_size;
  Params p{};
  const float* const* in = (const float* const*)d_in;
  p.x = in[0]; p.ln_in_g = in[1]; p.ln_in_b = in[2]; p.w_in = in[3];
  p.ssd_conv_w = in[4]; p.ssd_conv_b = in[5]; p.ssd_dt_bias = in[6]; p.ssd_a_log = in[7]; p.ssd_d = in[8]; p.ssd_norm_w = in[9];
  p.dn_conv_w = in[10]; p.dn_a_log = in[11]; p.dn_dt_bias = in[12]; p.dn_norm_w = in[13];
  p.sg_ln_g = in[14]; p.sg_ln_b = in[15]; p.sg_w = in[16]; p.sg_b = in[17];
  p.fox_f_bias = in[18]; p.gate_b = in[19]; p.w_branch = in[20]; p.w_out = in[21];
  p.ln1_g = in[22]; p.ln1_b = in[23]; p.w_up = in[24]; p.w_down = in[25]; p.ln2_g = in[26]; p.ln2_b = in[27];
  p.hf = (float*)d_out;
  char* ws = (char*)d_ws;
  size_t off = 0;
  auto take = [&](size_t bytes) { char* r = ws + off; off += (bytes + 255) & ~(size_t)255; return r; };
  p.ctrl = (unsigned*)take(16384);
  p.hb = (bf16_t*)take((size_t)MTOK * 1024 * 2);
  char* seg0 = ws + off;
  p.Z = (bf16_t*)take((size_t)MTOK * 512 * 2);
  p.XBC = (bf16_t*)take((size_t)MTOK * 1024 * 2);
  p.DNQKV = (bf16_t*)take((size_t)MTOK * 1536 * 2);
  p.DNG = (bf16_t*)take((size_t)MTOK * 512 * 2);
  p.SGUV = (bf16_t*)take((size_t)MTOK * 1024 * 2);
  p.FOXQKV = (bf16_t*)take((size_t)MTOK * 1536 * 2);
  p.U = (bf16_t*)seg0;
  p.small = (float*)take((size_t)MTOK * 32 * 4);
  p.cbuf = (float*)take((size_t)64 * SEQL * 4);
  p.ssqp = (float*)take((size_t)MTOK * 8 * 4);
  p.halo = (bf16_t*)take((size_t)512 * 3 * 2560 * 2);
  p.WinT = (bf16_t*)take((size_t)NWIN * 1024 * 2);
  p.WbT = (bf16_t*)take((size_t)4 * 1024 * 512 * 2);
  p.WoT = (bf16_t*)take((size_t)1024 * 1024 * 2);
  p.WupT = (bf16_t*)take((size_t)4096 * 1024 * 2);
  p.WdnT = (bf16_t*)take((size_t)1024 * 4096 * 2);
  if (off > ws_size) { fprintf(stderr, "workspace too small: need %zu have %zu\n", off, ws_size); return; }
  static int grid_blocks = 0;
  if (!grid_blocks) {
    hipFuncSetAttribute((const void*)hybrid_fwd, hipFuncAttributeMaxDynamicSharedMemorySize, (int)LDS_BYTES);
    int dev = 0, cus = 0, per_cu = 0;
    hipGetDevice(&dev);
    hipDeviceGetAttribute(&cus, hipDeviceAttributeMultiprocessorCount, dev);
    hipOccupancyMaxActiveBlocksPerMultiprocessor(&per_cu, hybrid_fwd, NT, LDS_BYTES);
    if (per_cu < 1) per_cu = 1;
    grid_blocks = cus * per_cu;
  }
  hipMemsetAsync(p.ctrl, 0, 16384, stream);
  void* args[] = {&p};
  hipError_t e = hipLaunchCooperativeKernel((void*)hybrid_fwd, dim3(grid_blocks), dim3(NT), args, LDS_BYTES, stream);
  if (e != hipSuccess) fprintf(stderr, "cooperative launch failed: %s (grid %d)\n", hipGetErrorString(e), grid_blocks);
}
```

```cpp
#include <hip/hip_runtime.h>
#include <hip/hip_cooperative_groups.h>
#include <cstdio>
#include <cstdint>
namespace cg = cooperative_groups;

typedef unsigned short bf16_t;
typedef short bf16x8 __attribute__((ext_vector_type(8)));
typedef float f32x4 __attribute__((ext_vector_type(4)));
typedef float f32x16 __attribute__((ext_vector_type(16)));
typedef unsigned u32x4 __attribute__((ext_vector_type(4)));
typedef unsigned u32x2 __attribute__((ext_vector_type(2)));

constexpr int NT = 512;
constexpr int MTOK = 32768, SEQL = 4096, DM = 1024, DFF = 4096;
constexpr int DIN = 10264;
constexpr int NPROJ = 6400;
constexpr int NWIN = 6400 + 4096;
constexpr size_t LDS_BYTES = 163840;
constexpr float ALPHA = 1.4142135623730951f;

struct Params {
  const float* x; const float* ln_in_g; const float* ln_in_b; const float* w_in;
  const float* ssd_conv_w; const float* ssd_conv_b; const float* ssd_dt_bias; const float* ssd_a_log; const float* ssd_d; const float* ssd_norm_w;
  const float* dn_conv_w; const float* dn_a_log; const float* dn_dt_bias; const float* dn_norm_w;
  const float* sg_ln_g; const float* sg_ln_b; const float* sg_w; const float* sg_b;
  const float* fox_f_bias; const float* gate_b; const float* w_branch; const float* w_out;
  const float* ln1_g; const float* ln1_b; const float* w_up; const float* w_down; const float* ln2_g; const float* ln2_b;
  float* hf;
  unsigned* ctrl;
  bf16_t* hb;
  bf16_t* Z;
  bf16_t* XBC;
  bf16_t* DNQKV;
  bf16_t* DNG;
  bf16_t* SGUV;
  bf16_t* FOXQKV;
  float* small;
  float* cbuf;
  float* ssqp;
  bf16_t* halo;
  bf16_t* WinT;
  bf16_t* WbT;
  bf16_t* WoT;
  bf16_t* WupT;
  bf16_t* WdnT;
  bf16_t* U;
};

typedef float f32x2_t __attribute__((ext_vector_type(2)));
typedef __bf16 bf16x2_t __attribute__((ext_vector_type(2)));
__device__ __forceinline__ unsigned pk_bf16(float lo, float hi) { f32x2_t v = {lo, hi}; bf16x2_t b = __builtin_convertvector(v, bf16x2_t); unsigned r; __builtin_memcpy(&r, &b, 4); return r; }
__device__ __forceinline__ bf16_t f2bf(float x) { return (bf16_t)(pk_bf16(x, 0.f) & 0xffffu); }
__device__ __forceinline__ float bf2f(bf16_t x) { return __uint_as_float(((unsigned)x) << 16); }
__device__ __forceinline__ float bflo(unsigned w) { return __uint_as_float(w << 16); }
__device__ __forceinline__ float bfhi(unsigned w) { return __uint_as_float(w & 0xffff0000u); }
__device__ __forceinline__ float sigmoidf_(float x) { return __builtin_amdgcn_rcpf(1.f + __expf(-x)); }
__device__ __forceinline__ float siluf_(float x) { return x * __builtin_amdgcn_rcpf(1.f + __expf(-x)); }
__device__ __forceinline__ float softplusf_(float x) { return fmaxf(x, 0.f) + log1pf(__expf(-fabsf(x))); }
__device__ __forceinline__ float logsigmoidf_(float x) { return fminf(x, 0.f) - log1pf(__expf(-fabsf(x))); }
__device__ __forceinline__ float geluf_(float x) {
  const float y = 0.7978845608028654f * (x + 0.044715f * x * x * x);
  const float t = 1.f - 2.f * __builtin_amdgcn_rcpf(__expf(2.f * y) + 1.f);
  return 0.5f * x * (1.f + t);
}
__device__ __forceinline__ int opq(int x) { asm("" : "+v"(x)); return x; }
__device__ __forceinline__ int tidx() { int t = threadIdx.x; asm volatile("" : "+v"(t)); return t; }
__device__ __forceinline__ int bidx() { int t = blockIdx.x; asm volatile("" : "+s"(t)); return t; }
__device__ __forceinline__ float wave_sum(float v) {
#pragma unroll
  for (int o = 32; o >= 1; o >>= 1) v += __shfl_xor(v, o);
  return v;
}
__device__ __forceinline__ f32x4 mma16(const bf16_t* P, int ldp, const bf16_t* Q, int ldq, int K, f32x4 acc, int lane) {
  const bf16_t* a = P + (lane & 15) * ldp + (lane >> 4) * 8;
  const bf16_t* b = Q + (lane & 15) * ldq + (lane >> 4) * 8;
  for (int k = 0; k < K; k += 32)
    acc = __builtin_amdgcn_mfma_f32_16x16x32_bf16(*(const bf16x8*)(a + k), *(const bf16x8*)(b + k), acc, 0, 0, 0);
  return acc;
}

template <int MI, int NI>
__device__ __forceinline__ void gemm_mainloop(const bf16_t* __restrict__ A, int lda, const bf16_t* __restrict__ Bt, int ldb, int K,
                                              char* lds, f32x16 (&acc)[MI][NI]) {
  constexpr int BM = 64 * MI, BN = 128 * NI, ACH = MI, BCH = 2 * NI, LDT = 72;
  constexpr int A_BYTES = BM * LDT * 2, B_BYTES = BN * LDT * 2, STAGE = A_BYTES + B_BYTES;
  const int tid = tidx(), lane = tid & 63, wave = tid >> 6, wm = wave >> 2, wn = wave & 3;
  u32x4 ra[ACH], rb[BCH];
  const int nk = K / 64;
  const int lrow = tid >> 3, lkc = (tid & 7) * 8;
  const bf16_t* ga = A + (size_t)lrow * lda + lkc;
  const bf16_t* gb = Bt + (size_t)lrow * ldb + lkc;
#pragma unroll
  for (int i = 0; i < ACH; ++i) ra[i] = *(const u32x4*)(ga + (size_t)(64 * i) * lda);
#pragma unroll
  for (int i = 0; i < BCH; ++i) rb[i] = *(const u32x4*)(gb + (size_t)(64 * i) * ldb);
  {
    char* base = lds;
#pragma unroll
    for (int i = 0; i < ACH; ++i) *(u32x4*)(base + ((lrow + 64 * i) * LDT + lkc) * 2) = ra[i];
#pragma unroll
    for (int i = 0; i < BCH; ++i) *(u32x4*)(base + A_BYTES + ((lrow + 64 * i) * LDT + lkc) * 2) = rb[i];
  }
  __syncthreads();
  const int aoff = ((wm * MI * 32 + (lane & 31)) * LDT + (lane >> 5) * 8) * 2;
  const int boff = A_BYTES + ((wn * NI * 32 + (lane & 31)) * LDT + (lane >> 5) * 8) * 2;
  for (int kt = 0; kt < nk; ++kt) {
    if (kt + 1 < nk) {
#pragma unroll
      for (int i = 0; i < ACH; ++i) ra[i] = *(const u32x4*)(ga + (size_t)(64 * i) * lda + (kt + 1) * 64);
#pragma unroll
      for (int i = 0; i < BCH; ++i) rb[i] = *(const u32x4*)(gb + (size_t)(64 * i) * ldb + (kt + 1) * 64);
    }
    const char* st = lds + (kt & 1) * STAGE;
#pragma unroll
    for (int k16 = 0; k16 < 4; ++k16) {
      bf16x8 a[MI], b[NI];
#pragma unroll
      for (int mi = 0; mi < MI; ++mi) a[mi] = *(const bf16x8*)(st + aoff + (mi * 32 * LDT + k16 * 16) * 2);
#pragma unroll
      for (int ni = 0; ni < NI; ++ni) b[ni] = *(const bf16x8*)(st + boff + (ni * 32 * LDT + k16 * 16) * 2);
#pragma unroll
      for (int mi = 0; mi < MI; ++mi)
#pragma unroll
        for (int ni = 0; ni < NI; ++ni) acc[mi][ni] = __builtin_amdgcn_mfma_f32_32x32x16_bf16(b[ni], a[mi], acc[mi][ni], 0, 0, 0);
    }
    if (kt + 1 < nk) {
      char* base = lds + ((kt + 1) & 1) * STAGE;
#pragma unroll
      for (int i = 0; i < ACH; ++i) *(u32x4*)(base + ((lrow + 64 * i) * LDT + lkc) * 2) = ra[i];
#pragma unroll
      for (int i = 0; i < BCH; ++i) *(u32x4*)(base + A_BYTES + ((lrow + 64 * i) * LDT + lkc) * 2) = rb[i];
    }
    __syncthreads();
  }
}
template <int MI, int NI>
__device__ __forceinline__ void zero_acc(f32x16 (&acc)[MI][NI]) {
#pragma unroll
  for (int mi = 0; mi < MI; ++mi)
#pragma unroll
    for (int ni = 0; ni < NI; ++ni)
#pragma unroll
      for (int r = 0; r < 16; ++r) acc[mi][ni][r] = 0.f;
}

namespace pg8 {
#define PG8_LAS __attribute__((address_space(3)))
constexpr int BM = 256, BK = 64, HALF = 128, HTB = HALF * BK * 2  , STAGE_BYTES = 8 * HTB, NXCD = 8, WGM = 8;

__host__ __device__ __forceinline__ int lds_byte(int r, int c) { const int st = (r >> 4) * 2 + (c >> 5), rr = r & 15, cc = c & 31, ob = rr * 64 + cc * 2; return st * 1024 + (ob ^ (((ob >> 9) & 1) << 5)); }
__host__ __device__ __forceinline__ void stage_rc(int b, int& R, int& C) { const int st = b / 1024, sb = b % 1024, swz = sb ^ (((sb >> 9) & 1) << 5); R = (st >> 1) * 16 + swz / 64; C = (st & 1) * 32 + (swz % 64) / 2; }
__host__ __device__ __forceinline__ int perm32(int rho) { const int n = rho >> 4, i = rho & 15; return 8 * (i >> 2) + 4 * n + (i & 3); }
struct Unit { int pm, pn; };
struct Gemm { const bf16_t* A; const bf16_t* Bt; int M, N, K; };

struct StaticOrder {
    int nM, nN, nwg, G, c;
    __host__ __device__ void init(int M, int N, int G_, int c_) { nM = M / BM; nN = N / BM; nwg = nM * nN; G = G_; c = c_; }
    __host__ __device__ bool next(int i, Unit& u) const {
        const long L = (long)i * G + c; if (L >= nwg) return false;
        int wgid = (int)L; { const int q = nwg / NXCD, r = nwg % NXCD, xcd = wgid % NXCD, off = wgid / NXCD; wgid = (xcd < r ? xcd * (q + 1) : r * (q + 1) + (xcd - r) * q) + off; }
        const int nig = WGM * nN, gid = wgid / nig, fm = gid * WGM, gsz = (nM - fm) < WGM ? (nM - fm) : WGM;
        u.pm = fm + ((wgid % nig) % gsz); u.pn = (wgid % nig) / gsz; return true;
    }
    __device__ __forceinline__ void a_ready(const Unit&) const {}
    __device__ __forceinline__ void done(const Unit&) const {}
};
template <class Epi, class Sched, bool ALIGN_EPI = false, bool SP2 = false>
__device__ __forceinline__ void gemm_phase(PG8_LAS unsigned char* lds, const Gemm g, const Sched& S, const Epi& E) {
    const int tid = tidx(), wid = __builtin_amdgcn_readfirstlane(tid >> 6), lane = tid & 63, wr = wid >> 2, wc = wid & 3, fr = lane & 15, fq = lane >> 4;
    const int K = g.K, nt = K / BK;
    unsigned voffA[2], voffB[2];
#pragma unroll
    for (int i = 0; i < 2; ++i) { int R, C; stage_rc(tid * 16 + i * 8192, R, C); const int Rb = Epi::PERM ? ((R & ~31) + perm32(R & 31)) : R;
        voffA[i] = (unsigned)(R * K + C) * 2u; voffB[i] = (unsigned)(Rb * K + C) * 2u; }
    const size_t kstep = (size_t)(BK * 2);
    const size_t hstep = (size_t)HALF * K * 2;
    const size_t tstep = 2 * hstep;
    const unsigned ldsw = (unsigned)wid * 1024u;
    const int aoff = lds_byte(wr * 64 + fr, fq * 8), boff = lds_byte(wc * 32 + fr, fq * 8);
#define PG8_SA(b, h) (((b) * 2 + (h)) * HTB)
#define PG8_SB(b, h) ((4 + (b) * 2 + (h)) * HTB)
#define PG8_STAGE(bufoff, gbase, voff) do { _Pragma("unroll") for (int _i = 0; _i < 2; ++_i) \
        __builtin_amdgcn_global_load_lds((const unsigned*)((const char*)(gbase) + (voff)[_i]), (PG8_LAS unsigned*)(lds + (bufoff) + ldsw + _i * 8192), 16, 0, 0); } while (0)
#define PG8_LDA(dst, b, h) do { _Pragma("unroll") for (int m = 0; m < 4; ++m) _Pragma("unroll") for (int k = 0; k < 2; ++k) dst[m][k] = *(const PG8_LAS bf16x8*)(lds + PG8_SA(b, h) + aoff + m * 2048 + k * 1024); } while (0)
#define PG8_LDB(dst, b, h) do { _Pragma("unroll") for (int n = 0; n < 2; ++n) _Pragma("unroll") for (int k = 0; k < 2; ++k) dst[n][k] = *(const PG8_LAS bf16x8*)(lds + PG8_SB(b, h) + boff + n * 2048 + k * 1024); } while (0)
#define PG8_MMA(ai, bj, At, Bt) do { __builtin_amdgcn_s_setprio(1); _Pragma("unroll") for (int m = 0; m < 4; ++m) _Pragma("unroll") for (int n = 0; n < 2; ++n) _Pragma("unroll") for (int k = 0; k < 2; ++k) \
        acc[ai][bj][m][n] = __builtin_amdgcn_mfma_f32_16x16x32_bf16(Bt[n][k], At[m][k], acc[ai][bj][m][n], 0, 0, 0); __builtin_amdgcn_s_setprio(0); } while (0)
#define PG8_WAIT_V(n) asm volatile("s_waitcnt vmcnt(" #n ")" ::: "memory")
#define PG8_WAIT_L(n) asm volatile("s_waitcnt lgkmcnt(" #n ")" ::: "memory")
#define PG8_BAR __builtin_amdgcn_s_barrier()
#define PG8_SCHED __builtin_amdgcn_sched_barrier(0)
    Unit cur, nxt; int ui = 0;
    if (!S.next(0, cur)) return;
    f32x4 acc[2][2][4][2];
#pragma unroll
    for (int a = 0; a < 2; ++a)
#pragma unroll
        for (int b = 0; b < 2; ++b)
#pragma unroll
            for (int m = 0; m < 4; ++m)
#pragma unroll
                for (int n = 0; n < 2; ++n) acc[a][b][m][n] = (f32x4){0.f, 0.f, 0.f, 0.f};
    bf16x8 At[4][2], B0[2][2], B1[2][2];
    const char* cA = (const char*)g.A + (size_t)cur.pm * tstep; const char* cB = (const char*)g.Bt + (size_t)cur.pn * tstep;
    S.a_ready(cur);
    if constexpr (SP2) {
        PG8_STAGE(PG8_SB(0, 0), cB, voffB); PG8_STAGE(PG8_SB(0, 1), cB + hstep, voffB); PG8_STAGE(PG8_SA(0, 0), cA, voffA); PG8_STAGE(PG8_SA(0, 1), cA + hstep, voffA);
        if (wr == 1) PG8_BAR;
        PG8_WAIT_V(2); PG8_BAR;
        PG8_STAGE(PG8_SB(1, 0), cB + kstep, voffB); PG8_STAGE(PG8_SA(1, 0), cA + kstep, voffA); PG8_STAGE(PG8_SB(1, 1), cB + hstep + kstep, voffB);
        PG8_WAIT_V(6); PG8_BAR;
    } else {
        PG8_STAGE(PG8_SB(0, 0), cB, voffB); PG8_STAGE(PG8_SA(0, 0), cA, voffA); PG8_STAGE(PG8_SB(0, 1), cB + hstep, voffB); PG8_STAGE(PG8_SA(0, 1), cA + hstep, voffA);
        if (wr == 1) PG8_BAR;
        PG8_WAIT_V(4); PG8_BAR;
        PG8_STAGE(PG8_SB(1, 0), cB + kstep, voffB); PG8_STAGE(PG8_SA(1, 0), cA + kstep, voffA); PG8_STAGE(PG8_SB(1, 1), cB + hstep + kstep, voffB);
        PG8_WAIT_V(6); PG8_BAR;
    }
    for (;;) {
        const bool has_next = S.next(ui + 1, nxt);
        const char* nA = has_next ? (const char*)g.A + (size_t)nxt.pm * tstep : cA; const char* nB = has_next ? (const char*)g.Bt + (size_t)nxt.pn * tstep : cB;
        for (int t = 0; t < nt; t += 2) {
            const bool last = (t == nt - 2);
            const char* a1 = cA + (size_t)(t + 1) * kstep;
            const char* a2 = last ? nA : cA + (size_t)(t + 2) * kstep; const char* b2 = last ? nB : cB + (size_t)(t + 2) * kstep;
            const char* a3 = a2 + kstep; const char* b3 = b2 + kstep;
            if (last && has_next) S.a_ready(nxt);
            if constexpr (SP2) {
            PG8_LDB(B0, 0, 0); PG8_LDB(B1, 0, 1); PG8_SCHED; PG8_LDA(At, 0, 0); PG8_STAGE(PG8_SA(1, 1), a1 + hstep, voffA);
            PG8_WAIT_V(8); PG8_WAIT_L(0); PG8_BAR; PG8_MMA(0, 0, At, B0); PG8_MMA(0, 1, At, B1); PG8_BAR; PG8_SCHED;
            PG8_LDA(At, 0, 1); PG8_STAGE(PG8_SB(0, 0), b2, voffB); PG8_STAGE(PG8_SB(0, 1), b2 + hstep, voffB); PG8_STAGE(PG8_SA(0, 0), a2, voffA);
            PG8_WAIT_V(8); PG8_WAIT_L(0); PG8_BAR; PG8_MMA(1, 0, At, B0); PG8_MMA(1, 1, At, B1); PG8_BAR; PG8_SCHED;
            PG8_LDB(B0, 1, 0); PG8_LDB(B1, 1, 1); PG8_SCHED; PG8_LDA(At, 1, 0); PG8_STAGE(PG8_SA(0, 1), a2 + hstep, voffA);
            PG8_WAIT_V(8); PG8_WAIT_L(0); PG8_BAR; PG8_MMA(0, 0, At, B0); PG8_MMA(0, 1, At, B1); PG8_BAR; PG8_SCHED;
            PG8_LDA(At, 1, 1); PG8_STAGE(PG8_SB(1, 0), b3, voffB); PG8_STAGE(PG8_SB(1, 1), b3 + hstep, voffB); PG8_STAGE(PG8_SA(1, 0), a3, voffA);
            PG8_WAIT_V(8); PG8_WAIT_L(0); PG8_BAR; PG8_MMA(1, 0, At, B0); PG8_MMA(1, 1, At, B1); PG8_BAR; PG8_SCHED;
            } else {
            PG8_LDB(B0, 0, 0); PG8_SCHED; PG8_LDA(At, 0, 0); PG8_STAGE(PG8_SA(1, 1), a1 + hstep, voffA);
            PG8_WAIT_L(8); PG8_BAR; PG8_WAIT_L(0); PG8_MMA(0, 0, At, B0); PG8_BAR; PG8_SCHED;
            PG8_LDB(B1, 0, 1); PG8_STAGE(PG8_SB(0, 0), b2, voffB);
            PG8_BAR; PG8_WAIT_L(0); PG8_MMA(0, 1, At, B1); PG8_BAR;
            PG8_LDA(At, 0, 1); PG8_STAGE(PG8_SA(0, 0), a2, voffA);
            PG8_BAR; PG8_WAIT_L(0); PG8_MMA(1, 0, At, B0); PG8_BAR; PG8_SCHED;
            PG8_STAGE(PG8_SB(0, 1), b2 + hstep, voffB);
            PG8_WAIT_V(6); PG8_BAR; PG8_MMA(1, 1, At, B1); PG8_BAR;
            PG8_LDB(B0, 1, 0); PG8_SCHED; PG8_LDA(At, 1, 0); PG8_STAGE(PG8_SA(0, 1), a2 + hstep, voffA);
            PG8_WAIT_L(8); PG8_BAR; PG8_WAIT_L(0); PG8_MMA(0, 0, At, B0); PG8_BAR; PG8_SCHED;
            PG8_LDB(B1, 1, 1); PG8_STAGE(PG8_SB(1, 0), b3, voffB);
            PG8_BAR; PG8_WAIT_L(0); PG8_MMA(0, 1, At, B1); PG8_BAR;
            PG8_LDA(At, 1, 1); PG8_STAGE(PG8_SA(1, 0), a3, voffA);
            PG8_BAR; PG8_WAIT_L(0); PG8_MMA(1, 0, At, B0); PG8_BAR; PG8_SCHED;
            PG8_STAGE(PG8_SB(1, 1), b3 + hstep, voffB);
            PG8_WAIT_V(6); PG8_BAR; PG8_MMA(1, 1, At, B1); PG8_BAR;
            }
        }
        if constexpr (ALIGN_EPI) { if (wr == 0) PG8_BAR; }
        if constexpr (!Epi::AFTER_DRAIN) { E(acc, cur, wr, wc, fr, fq); S.done(cur); }
        if (!has_next) break;
#pragma unroll
        for (int a = 0; a < 2; ++a)
#pragma unroll
            for (int b = 0; b < 2; ++b)
#pragma unroll
                for (int m = 0; m < 4; ++m)
#pragma unroll
                    for (int n = 0; n < 2; ++n) acc[a][b][m][n] = (f32x4){0.f, 0.f, 0.f, 0.f};
        cur = nxt; cA = nA; cB = nB; ++ui;
        if constexpr (ALIGN_EPI) { if (wr == 1) PG8_BAR; }
    }
    PG8_WAIT_V(0);
    if constexpr (!ALIGN_EPI) { if (wr == 0) PG8_BAR; }
    PG8_BAR;
    if constexpr (Epi::AFTER_DRAIN) { E.fused(acc, cur, wr, wc, fr, fq, lds, wid, lane); S.done(cur); }
#undef PG8_SA
#undef PG8_SB
#undef PG8_STAGE
#undef PG8_LDA
#undef PG8_LDB
#undef PG8_MMA
#undef PG8_WAIT_V
#undef PG8_WAIT_L
#undef PG8_BAR
#undef PG8_SCHED
}
}


template <int MI, int NI, bool PERMB = false>
__device__ __forceinline__ void gemm_mainloop_dma(const bf16_t* __restrict__ A, int lda, const bf16_t* __restrict__ Bt, int ldb, int K,
                                                  PG8_LAS unsigned char* lds3, f32x16 (&acc)[MI][NI]) {
  constexpr int BM = 64 * MI, BN = 128 * NI;
  constexpr int A_BYTES = BM * 128, B_BYTES = BN * 128, STAGE = A_BYTES + B_BYTES;
  constexpr int APIECES = BM / 8 / 8, BPIECES = BN / 8 / 8;
  const int tid = tidx(), lane = tid & 63, wave = __builtin_amdgcn_readfirstlane(tid >> 6), wm = wave >> 2, wn = wave & 3;
  const int nk = K / 64;
  const int prow = lane >> 3;
  unsigned offA[APIECES], offB[BPIECES];
#pragma unroll
  for (int i = 0; i < APIECES; ++i) { const int row = (wave * APIECES + i) * 8 + prow; offA[i] = (unsigned)(row * lda + (((lane & 7) ^ ((row >> 1) & 7)) * 8)); }
#pragma unroll
  for (int i = 0; i < BPIECES; ++i) { const int row = (wave * BPIECES + i) * 8 + prow; const int grow = PERMB ? (((row >> 5) & 1) * 128 + (row >> 6) * 32 + (row & 31)) : row;
    offB[i] = (unsigned)(grow * ldb + (((lane & 7) ^ ((row >> 1) & 7)) * 8)); }
  auto stage = [&](int st, int kt) {
    PG8_LAS unsigned char* base = lds3 + st * STAGE;
#pragma unroll
    for (int i = 0; i < APIECES; ++i)
      __builtin_amdgcn_global_load_lds((const unsigned*)(A + offA[i] + kt * 64), (PG8_LAS unsigned*)(base + (wave * APIECES + i) * 1024), 16, 0, 0);
#pragma unroll
    for (int i = 0; i < BPIECES; ++i)
      __builtin_amdgcn_global_load_lds((const unsigned*)(Bt + offB[i] + kt * 64), (PG8_LAS unsigned*)(base + A_BYTES + (wave * BPIECES + i) * 1024), 16, 0, 0);
  };
  stage(0, 0);
  asm volatile("s_waitcnt vmcnt(0)" ::: "memory");
  __builtin_amdgcn_s_barrier();
  const int ar = wm * MI * 32 + (lane & 31), br = wn * NI * 32 + (lane & 31), ch = lane >> 5;
  for (int kt = 0; kt < nk; ++kt) {
    if (kt + 1 < nk) stage((kt + 1) & 1, kt + 1);
    PG8_LAS const unsigned char* sa = lds3 + (kt & 1) * STAGE;
    PG8_LAS const unsigned char* sb = sa + A_BYTES;
#pragma unroll
    for (int k16 = 0; k16 < 4; ++k16) {
      bf16x8 a[MI], b[NI];
#pragma unroll
      for (int mi = 0; mi < MI; ++mi) { const int r = ar + mi * 32; a[mi] = *(PG8_LAS const bf16x8*)(sa + r * 128 + (((k16 * 2 + ch) ^ ((r >> 1) & 7)) * 16)); }
#pragma unroll
      for (int ni = 0; ni < NI; ++ni) { const int r = br + ni * 32; b[ni] = *(PG8_LAS const bf16x8*)(sb + r * 128 + (((k16 * 2 + ch) ^ ((r >> 1) & 7)) * 16)); }
#pragma unroll
      for (int mi = 0; mi < MI; ++mi)
#pragma unroll
        for (int ni = 0; ni < NI; ++ni) acc[mi][ni] = __builtin_amdgcn_mfma_f32_32x32x16_bf16(b[ni], a[mi], acc[mi][ni], 0, 0, 0);
    }
    asm volatile("s_waitcnt vmcnt(0) lgkmcnt(0)" ::: "memory");
    __builtin_amdgcn_s_barrier();
  }
}


template <int MI, int NI>
__device__ __forceinline__ void gemm_mainloop_dma128(const bf16_t* __restrict__ A, int lda, const bf16_t* __restrict__ Bt, int ldb, int K,
                                                     PG8_LAS unsigned char* lds3, f32x16 (&acc)[MI][NI]) {
  constexpr int BM = 64 * MI, BN = 128 * NI;
  constexpr int A_BYTES = BM * 256, B_BYTES = BN * 256, STAGE = A_BYTES + B_BYTES;
  constexpr int APIECES = BM / 4 / 8, BPIECES = BN / 4 / 8;
  const int tid = tidx(), lane = tid & 63, wave = __builtin_amdgcn_readfirstlane(tid >> 6), wm = wave >> 2, wn = wave & 3;
  const int nk = K / 128;
  const int prow = lane >> 4;
  unsigned offA[APIECES], offB[BPIECES];
#pragma unroll
  for (int i = 0; i < APIECES; ++i) { const int row = (wave * APIECES + i) * 4 + prow; offA[i] = (unsigned)(row * lda + (((lane & 15) ^ (row & 15)) * 8)); }
#pragma unroll
  for (int i = 0; i < BPIECES; ++i) { const int row = (wave * BPIECES + i) * 4 + prow; offB[i] = (unsigned)(row * ldb + (((lane & 15) ^ (row & 15)) * 8)); }
  auto stage = [&](int st, int kt) {
    PG8_LAS unsigned char* base = lds3 + st * STAGE;
#pragma unroll
    for (int i = 0; i < APIECES; ++i)
      __builtin_amdgcn_global_load_lds((const unsigned*)(A + offA[i] + kt * 128), (PG8_LAS unsigned*)(base + (wave * APIECES + i) * 1024), 16, 0, 0);
#pragma unroll
    for (int i = 0; i < BPIECES; ++i)
      __builtin_amdgcn_global_load_lds((const unsigned*)(Bt + offB[i] + kt * 128), (PG8_LAS unsigned*)(base + A_BYTES + (wave * BPIECES + i) * 1024), 16, 0, 0);
  };
  stage(0, 0);
  asm volatile("s_waitcnt vmcnt(0)" ::: "memory");
  __builtin_amdgcn_s_barrier();
  const int ar = wm * MI * 32 + (lane & 31), br = wn * NI * 32 + (lane & 31), ch = lane >> 5;
  for (int kt = 0; kt < nk; ++kt) {
    if (kt + 1 < nk) stage((kt + 1) & 1, kt + 1);
    PG8_LAS const unsigned char* sa = lds3 + (kt & 1) * STAGE;
    PG8_LAS const unsigned char* sb = sa + A_BYTES;
#pragma unroll
    for (int k16 = 0; k16 < 8; ++k16) {
      bf16x8 a[MI], b[NI];
#pragma unroll
      for (int mi = 0; mi < MI; ++mi) { const int r = ar + mi * 32; a[mi] = *(PG8_LAS const bf16x8*)(sa + r * 256 + (((k16 * 2 + ch) ^ (r & 15)) * 16)); }
#pragma unroll
      for (int ni = 0; ni < NI; ++ni) { const int r = br + ni * 32; b[ni] = *(PG8_LAS const bf16x8*)(sb + r * 256 + (((k16 * 2 + ch) ^ (r & 15)) * 16)); }
#pragma unroll
      for (int mi = 0; mi < MI; ++mi)
#pragma unroll
        for (int ni = 0; ni < NI; ++ni) acc[mi][ni] = __builtin_amdgcn_mfma_f32_32x32x16_bf16(b[ni], a[mi], acc[mi][ni], 0, 0, 0);
    }
    asm volatile("s_waitcnt vmcnt(0) lgkmcnt(0)" ::: "memory");
    __builtin_amdgcn_s_barrier();
  }
}

__device__ __forceinline__ int map_win(int n) {
  if (n < 1536) return n;
  if (n < 3072) return n + 8;
  if (n < 6144) return n + 16;
  if (n < 6400) { const int j = n - 6144; if (j < 8) return 1536 + j; if (j < 12) return 3080 + (j - 8); if (j < 16) return 3084 + (j - 12); if (j < 24) return 6160 + (j - 16); return -1; }
  return n - 6400 + 6168;
}
__device__ void convert_tile(const float* __restrict__ src, int ldsrc, int K, bf16_t* __restrict__ dst, int nb, int kb, bool win, float* ls) {
  const int tid = tidx();
  {
    const int n = tid & 63, kk = tid >> 6;
    const int nd = nb * 64 + n;
    const int col = win ? map_win(nd) : nd;
#pragma unroll
    for (int i = 0; i < 8; ++i) {
      const int k = kk + 8 * i;
      ls[k * 65 + n] = (col >= 0) ? src[(size_t)(kb * 64 + k) * ldsrc + col] : 0.f;
    }
  }
  __syncthreads();
  {
    const int n = tid >> 3, ks = (tid & 7) * 8;
    u32x4 w;
    w.x = pk_bf16(ls[(ks + 0) * 65 + n], ls[(ks + 1) * 65 + n]);
    w.y = pk_bf16(ls[(ks + 2) * 65 + n], ls[(ks + 3) * 65 + n]);
    w.z = pk_bf16(ls[(ks + 4) * 65 + n], ls[(ks + 5) * 65 + n]);
    w.w = pk_bf16(ls[(ks + 6) * 65 + n], ls[(ks + 7) * 65 + n]);
    *(u32x4*)(dst + (size_t)(nb * 64 + n) * K + kb * 64 + ks) = w;
  }
  __syncthreads();
}
__device__ void convert_weights(const Params& p, int layer, char* lds) {
  float* ls = (float*)lds;
  constexpr int T0 = 164 * 16, T1 = T0 + 4 * 16 * 8, T2 = T1 + 256, T3 = T2 + 1024, T4 = T3 + 1024;
  for (int t = bidx(); t < T4; t += gridDim.x) {
    if (t < T0) { convert_tile(p.w_in + (size_t)layer * DM * DIN, DIN, 1024, p.WinT, t >> 4, t & 15, true, ls); }
    else if (t < T1) { const int u = t - T0, br = u >> 7, v = u & 127; convert_tile(p.w_branch + ((size_t)(layer * 4 + br)) * 512 * 1024, 1024, 512, p.WbT + (size_t)br * 1024 * 512, v >> 3, v & 7, false, ls); }
    else if (t < T2) { const int u = t - T1; convert_tile(p.w_out + (size_t)layer * 1024 * 1024, 1024, 1024, p.WoT, u >> 4, u & 15, false, ls); }
    else if (t < T3) { const int u = t - T2; convert_tile(p.w_up + (size_t)layer * 1024 * 4096, 4096, 1024, p.WupT, u >> 4, u & 15, false, ls); }
    else { const int u = t - T3; convert_tile(p.w_down + (size_t)layer * 4096 * 1024, 1024, 4096, p.WdnT, u >> 6, u & 63, false, ls); }
  }
}

__device__ void ln_phase(const float* src, float* dstf, bf16_t* __restrict__ dstb, const float* __restrict__ g, const float* __restrict__ b) {
  const int lane = tidx() & 63, gw = bidx() * 8 + (tidx() >> 6), nw = gridDim.x * 8;
  f32x4 gv[4], bv[4];
#pragma unroll
  for (int i = 0; i < 4; ++i) { gv[i] = *(const f32x4*)(g + i * 256 + lane * 4); bv[i] = *(const f32x4*)(b + i * 256 + lane * 4); }
  f32x4 nx[4];
  if (gw < MTOK) {
#pragma unroll
    for (int i = 0; i < 4; ++i) nx[i] = *(const f32x4*)(src + (size_t)gw * DM + i * 256 + lane * 4);
  }
  for (int row = gw; row < MTOK; row += nw) {
    f32x4 v[4];
#pragma unroll
    for (int i = 0; i < 4; ++i) v[i] = nx[i];
    if (row + nw < MTOK) {
#pragma unroll
      for (int i = 0; i < 4; ++i) nx[i] = *(const f32x4*)(src + (size_t)(row + nw) * DM + i * 256 + lane * 4);
    }
    float s = 0.f;
#pragma unroll
    for (int i = 0; i < 4; ++i) s += (v[i][0] + v[i][1]) + (v[i][2] + v[i][3]);
    const float mu = wave_sum(s) * (1.f / 1024.f);
    float q = 0.f;
#pragma unroll
    for (int i = 0; i < 4; ++i) { v[i] = v[i] - mu; q += (v[i][0] * v[i][0] + v[i][1] * v[i][1]) + (v[i][2] * v[i][2] + v[i][3] * v[i][3]); }
    const float rstd = rsqrtf(wave_sum(q) * (1.f / 1024.f) + 1e-5f);
#pragma unroll
    for (int i = 0; i < 4; ++i) {
      f32x4 y = v[i] * rstd * gv[i] + bv[i];
      if (dstf) *(f32x4*)(dstf + (size_t)row * DM + i * 256 + lane * 4) = y;
      u32x2 w; w.x = pk_bf16(y[0], y[1]); w.y = pk_bf16(y[2], y[3]);
      *(u32x2*)(dstb + (size_t)row * DM + i * 256 + lane * 4) = w;
    }
  }
}

__device__ void inproj_phase(const Params& p, char* lds) {
  const int lane = tidx() & 63, wave = tidx() >> 6, wm = wave >> 2, wn = wave & 3;
  constexpr int NTN = NPROJ / 256;
  for (int t = bidx(); t < 128 * NTN; t += gridDim.x) {
    const int mt = t / NTN, nt = t % NTN, n0 = nt * 256;
    f32x16 acc[4][2];
    zero_acc<4, 2>(acc);
    gemm_mainloop<4, 2>(p.hb + (size_t)mt * 256 * DM, DM, p.WinT + (size_t)n0 * DM, DM, DM, lds, acc);
    bf16_t* dst; int ld, off;
    if (n0 < 512) { dst = p.Z; ld = 512; off = n0; }
    else if (n0 < 1536) { dst = p.XBC; ld = 1024; off = n0 - 512; }
    else if (n0 < 3072) { dst = p.DNQKV; ld = 1536; off = n0 - 1536; }
    else if (n0 < 3584) { dst = p.DNG; ld = 512; off = n0 - 3072; }
    else if (n0 < 4608) { dst = p.SGUV; ld = 1024; off = n0 - 3584; }
    else if (n0 < 6144) { dst = p.FOXQKV; ld = 1536; off = n0 - 4608; }
    else { dst = nullptr; ld = 0; off = 0; }
#pragma unroll
    for (int mi = 0; mi < 4; ++mi) {
      const int m = mt * 256 + wm * 128 + mi * 32 + (lane & 31);
#pragma unroll
      for (int ni = 0; ni < 2; ++ni)
#pragma unroll
        for (int q = 0; q < 4; ++q) {
          const int n = wn * 64 + ni * 32 + q * 8 + (lane >> 5) * 4;
          if (dst) {
            u32x2 w; w.x = pk_bf16(acc[mi][ni][q * 4 + 0], acc[mi][ni][q * 4 + 1]); w.y = pk_bf16(acc[mi][ni][q * 4 + 2], acc[mi][ni][q * 4 + 3]);
            *(u32x2*)(dst + (size_t)m * ld + off + n) = w;
          } else if (n < 32) {
            f32x4 v = {acc[mi][ni][q * 4 + 0], acc[mi][ni][q * 4 + 1], acc[mi][ni][q * 4 + 2], acc[mi][ni][q * 4 + 3]};
            *(f32x4*)(p.small + (size_t)m * 32 + n) = v;
          }
        }
    }
  }
}


struct EpiProj {
  static constexpr bool PERM = true, AFTER_DRAIN = false;
  Params p;
  __device__ __forceinline__ void operator()(const f32x4 (&acc)[2][2][4][2], const pg8::Unit& u, int wr, int wc, int fr, int fq) const {
    const int n0 = u.pn * 256;
    bf16_t* dst; int ld, off;
    if (n0 < 512) { dst = p.Z; ld = 512; off = n0; }
    else if (n0 < 1536) { dst = p.XBC; ld = 1024; off = n0 - 512; }
    else if (n0 < 3072) { dst = p.DNQKV; ld = 1536; off = n0 - 1536; }
    else if (n0 < 3584) { dst = p.DNG; ld = 512; off = n0 - 3072; }
    else if (n0 < 4608) { dst = p.SGUV; ld = 1024; off = n0 - 3584; }
    else if (n0 < 6144) { dst = p.FOXQKV; ld = 1536; off = n0 - 4608; }
    else { dst = nullptr; ld = 0; off = 0; }
    const int hch = (n0 >= 512 && n0 < 1536) ? (n0 - 512) : (n0 >= 1536 && n0 < 3072) ? (1024 + n0 - 1536) : -1;
#pragma unroll
    for (int ai = 0; ai < 2; ++ai)
#pragma unroll
      for (int m = 0; m < 4; ++m) {
        const size_t r = (size_t)u.pm * 256 + ai * 128 + wr * 64 + m * 16 + fr;
#pragma unroll
        for (int bj = 0; bj < 2; ++bj) {
          const int c = bj * 128 + wc * 32 + fq * 8;
          const f32x4 v0 = acc[ai][bj][m][0], v1 = acc[ai][bj][m][1];
          if (dst) {
            u32x4 w; w.x = pk_bf16(v0[0], v0[1]); w.y = pk_bf16(v0[2], v0[3]); w.z = pk_bf16(v1[0], v1[1]); w.w = pk_bf16(v1[2], v1[3]);
            *(u32x4*)(dst + r * ld + off + c) = w;
            if (hch >= 0 && ((int)r & 63) >= 61) {
              const int rr = ((int)r >> 6) + 1;
              if (rr < 512 && (rr & 63) != 0) *(u32x4*)(p.halo + ((size_t)rr * 3 + (((int)r & 63) - 61)) * 2560 + hch + c) = w;
            }
          } else if (c < 32) {
            *(f32x4*)(p.small + r * 32 + c) = v0; *(f32x4*)(p.small + r * 32 + c + 4) = v1;
          }
        }
      }
  }
};
struct EpiUp {
  static constexpr bool PERM = true, AFTER_DRAIN = false;
  bf16_t* U;
  __device__ __forceinline__ void operator()(const f32x4 (&acc)[2][2][4][2], const pg8::Unit& u, int wr, int wc, int fr, int fq) const {
#pragma unroll
    for (int ai = 0; ai < 2; ++ai)
#pragma unroll
      for (int m = 0; m < 4; ++m) {
        const size_t r = (size_t)u.pm * 256 + ai * 128 + wr * 64 + m * 16 + fr;
#pragma unroll
        for (int bj = 0; bj < 2; ++bj) {
          const int c = u.pn * 256 + bj * 128 + wc * 32 + fq * 8;
          f32x4 v0 = acc[ai][bj][m][0], v1 = acc[ai][bj][m][1];
#pragma unroll
          for (int j = 0; j < 4; ++j) { v0[j] = fmaxf(v0[j], 0.f); v0[j] *= v0[j]; v1[j] = fmaxf(v1[j], 0.f); v1[j] *= v1[j]; }
          u32x4 w; w.x = pk_bf16(v0[0], v0[1]); w.y = pk_bf16(v0[2], v0[3]); w.z = pk_bf16(v1[0], v1[1]); w.w = pk_bf16(v1[2], v1[3]);
          *(u32x4*)(U + r * DFF + c) = w;
        }
      }
  }
};
struct EpiResid {
  static constexpr bool PERM = true, AFTER_DRAIN = false;
  float* hf; const bf16_t* hb;
  __device__ __forceinline__ void operator()(const f32x4 (&acc)[2][2][4][2], const pg8::Unit& u, int wr, int wc, int fr, int fq) const {
#pragma unroll
    for (int ai = 0; ai < 2; ++ai) {
#pragma unroll
      for (int m = 0; m < 4; ++m) {
        const size_t r = (size_t)u.pm * 256 + ai * 128 + wr * 64 + m * 16 + fr;
#pragma unroll
        for (int bj = 0; bj < 2; ++bj) {
          const int c = u.pn * 256 + bj * 128 + wc * 32 + fq * 8;
          const u32x4 hv = *(const u32x4*)(hb + r * DM + c);
          f32x4 a = {bflo(hv.x), bfhi(hv.x), bflo(hv.y), bfhi(hv.y)}, b = {bflo(hv.z), bfhi(hv.z), bflo(hv.w), bfhi(hv.w)};
          a = a * ALPHA + acc[ai][bj][m][0]; b = b * ALPHA + acc[ai][bj][m][1];
          float* hp = hf + r * DM + c;
          *(f32x4*)hp = a; *(f32x4*)(hp + 4) = b;
        }
      }
      asm volatile("" ::: "memory");
    }
  }
};
template <class Epi>
__device__ __forceinline__ void pg8_phase(const bf16_t* A, const bf16_t* Bt, int N, int K, const Epi& E, PG8_LAS unsigned char* lds3) {
  pg8::Gemm g; g.A = A; g.Bt = Bt; g.M = MTOK; g.N = N; g.K = K;
  pg8::StaticOrder S; S.init(MTOK, N, (int)gridDim.x, bidx());
  pg8::gemm_phase<Epi, pg8::StaticOrder, true, true>(lds3, g, S, E);
  __syncthreads();
}

__device__ void foxc_phase(const Params& p, int layer, char* lds) {
  float* wsum = (float*)lds;
  const int tid = tidx(), lane = tid & 63, wave = tid >> 6;
  for (int it = bidx(); it < 64; it += gridDim.x) {
    const int b = it >> 3, h = it & 7;
    const float fb = p.fox_f_bias[layer * 8 + h];
    float v[8]; float s = 0.f;
#pragma unroll
    for (int i = 0; i < 8; ++i) { const int l = tid * 8 + i; v[i] = logsigmoidf_(p.small[(size_t)(b * SEQL + l) * 32 + 16 + h] + fb); s += v[i]; }
    float inc = s;
#pragma unroll
    for (int o = 1; o < 64; o <<= 1) { const float t = __shfl_up(inc, o); if (lane >= o) inc += t; }
    if (lane == 63) wsum[wave] = inc;
    __syncthreads();
    float base = inc - s;
    for (int w = 0; w < wave; ++w) base += wsum[w];
    float c = base;
    float* out = p.cbuf + (size_t)it * SEQL + tid * 8;
#pragma unroll
    for (int i = 0; i < 8; ++i) { c += v[i]; out[i] = c; }
    float km = 0.f;
    for (int i = 0; i < 8; ++i) {
      const bf16_t* kp = p.FOXQKV + (size_t)(b * SEQL + tid * 8 + i) * 1536 + 512 + h * 64;
      float ss = 0.f;
#pragma unroll
      for (int c8 = 0; c8 < 8; ++c8) {
        const u32x4 r = *(const u32x4*)(kp + c8 * 8);
        ss += bflo(r.x) * bflo(r.x) + bfhi(r.x) * bfhi(r.x) + bflo(r.y) * bflo(r.y) + bfhi(r.y) * bfhi(r.y)
            + bflo(r.z) * bflo(r.z) + bfhi(r.z) * bfhi(r.z) + bflo(r.w) * bflo(r.w) + bfhi(r.w) * bfhi(r.w);
      }
      km = fmaxf(km, ss);
    }
#pragma unroll
    for (int o = 32; o >= 1; o >>= 1) km = fmaxf(km, __shfl_xor(km, o));
    __syncthreads();
    if (lane == 0) wsum[wave] = km;
    __syncthreads();
    if (tid == 0) { float m = wsum[0]; for (int w = 1; w < 8; ++w) m = fmaxf(m, wsum[w]); ((float*)(p.ctrl + 64))[it] = sqrtf(m); }
    __syncthreads();
  }
}

__device__ void gates_halo_phase(const Params& p, int layer) {
  const int tid = tidx(), lane = tid & 63, gw = bidx() * 8 + (tid >> 6), nw = (int)gridDim.x * 8;
  for (int task = gw; task < 512 * 12; task += nw) {
    const int r = task / 12, hh = task % 12;
    const size_t t = (size_t)r * 64 + lane;
    if (hh < 8) {
      const float dt = softplusf_(p.small[t * 32 + hh] + p.ssd_dt_bias[layer * 8 + hh]);
      float inc = dt * -__expf(p.ssd_a_log[layer * 8 + hh]);
#pragma unroll
      for (int o = 1; o < 64; o <<= 1) { const float v = __shfl_up(inc, o); if (lane >= o) inc += v; }
      p.small[t * 32 + hh] = dt; p.small[t * 32 + 24 + hh] = inc;
    } else {
      const int h = hh - 8;
      const float be = sigmoidf_(p.small[t * 32 + 8 + h]);
      float inc = -__expf(p.dn_a_log[layer * 4 + h]) * softplusf_(p.small[t * 32 + 12 + h] + p.dn_dt_bias[layer * 4 + h]);
#pragma unroll
      for (int o = 1; o < 64; o <<= 1) { const float v = __shfl_up(inc, o); if (lane >= o) inc += v; }
      p.small[t * 32 + 8 + h] = be; p.small[t * 32 + 12 + h] = inc;
    }
  }
}

__device__ void conv_phase(const Params& p, int layer) {
  const int tid = tidx(), lane = tid & 63, gw = bidx() * 8 + (tid >> 6), nw = (int)gridDim.x * 8;
  for (int ww = gw; ww < 512 * 5; ww += nw) {
    const int r = ww / 5, cg = ww % 5, cc = cg * 64 + lane;
    bf16_t* base; int ld; const float* cw; float bias[8];
    if (cg < 2) {
      const int ch = cc * 8; base = p.XBC + ch; ld = 1024; cw = p.ssd_conv_w + (size_t)layer * 4 * 1024 + ch;
#pragma unroll
      for (int j = 0; j < 8; ++j) bias[j] = p.ssd_conv_b[layer * 1024 + ch + j];
    } else {
      const int ch = (cc - 128) * 8; base = p.DNQKV + ch; ld = 1536; cw = p.dn_conv_w + (size_t)layer * 4 * 1536 + ch;
#pragma unroll
      for (int j = 0; j < 8; ++j) bias[j] = 0.f;
    }
    const int wld = (cg < 2) ? 1024 : 1536;
    float w[4][8];
#pragma unroll
    for (int k = 0; k < 4; ++k) {
      const f32x4 a = *(const f32x4*)(cw + k * wld), b = *(const f32x4*)(cw + k * wld + 4);
      w[k][0] = a[0]; w[k][1] = a[1]; w[k][2] = a[2]; w[k][3] = a[3]; w[k][4] = b[0]; w[k][5] = b[1]; w[k][6] = b[2]; w[k][7] = b[3];
    }
    u32x4 h0 = {0u, 0u, 0u, 0u}, h1 = h0, h2 = h0;
    if ((r & 63) != 0) {
      const bf16_t* hp = p.halo + (size_t)r * 3 * 2560 + cc * 8;
      h0 = *(const u32x4*)hp; h1 = *(const u32x4*)(hp + 2560); h2 = *(const u32x4*)(hp + 5120);
    }
    bf16_t* rowp = base + (size_t)r * 64 * ld;
    const float qs = (cg == 2) ? 0.08838834764831845f : 1.f;
    u32x4 nxt[4];
#pragma unroll
    for (int i = 0; i < 4; ++i) nxt[i] = *(const u32x4*)(rowp + (size_t)i * ld);
    for (int i0 = 0; i0 < 64; i0 += 4) {
      u32x4 cur[4];
#pragma unroll
      for (int i = 0; i < 4; ++i) cur[i] = nxt[i];
      if (i0 + 4 < 64) {
#pragma unroll
        for (int i = 0; i < 4; ++i) nxt[i] = *(const u32x4*)(rowp + (size_t)(i0 + 4 + i) * ld);
      }
#pragma unroll
      for (int i = 0; i < 4; ++i) {
        const u32x4 c3 = cur[i];
        float a[8];
        a[0] = bias[0] + w[0][0] * bflo(h0.x) + w[1][0] * bflo(h1.x) + w[2][0] * bflo(h2.x) + w[3][0] * bflo(c3.x);
        a[1] = bias[1] + w[0][1] * bfhi(h0.x) + w[1][1] * bfhi(h1.x) + w[2][1] * bfhi(h2.x) + w[3][1] * bfhi(c3.x);
        a[2] = bias[2] + w[0][2] * bflo(h0.y) + w[1][2] * bflo(h1.y) + w[2][2] * bflo(h2.y) + w[3][2] * bflo(c3.y);
        a[3] = bias[3] + w[0][3] * bfhi(h0.y) + w[1][3] * bfhi(h1.y) + w[2][3] * bfhi(h2.y) + w[3][3] * bfhi(c3.y);
        a[4] = bias[4] + w[0][4] * bflo(h0.z) + w[1][4] * bflo(h1.z) + w[2][4] * bflo(h2.z) + w[3][4] * bflo(c3.z);
        a[5] = bias[5] + w[0][5] * bfhi(h0.z) + w[1][5] * bfhi(h1.z) + w[2][5] * bfhi(h2.z) + w[3][5] * bfhi(c3.z);
        a[6] = bias[6] + w[0][6] * bflo(h0.w) + w[1][6] * bflo(h1.w) + w[2][6] * bflo(h2.w) + w[3][6] * bflo(c3.w);
        a[7] = bias[7] + w[0][7] * bfhi(h0.w) + w[1][7] * bfhi(h1.w) + w[2][7] * bfhi(h2.w) + w[3][7] * bfhi(c3.w);
        float ss = 0.f;
#pragma unroll
        for (int j = 0; j < 8; ++j) { a[j] = siluf_(a[j]); ss += a[j] * a[j]; }
        float rn = 1.f;
        if (cg == 2 || cg == 3) {
          ss += __shfl_xor(ss, 1); ss += __shfl_xor(ss, 2); ss += __shfl_xor(ss, 4); ss += __shfl_xor(ss, 8);
          rn = rsqrtf(ss + 1e-6f) * qs;
        }
        u32x4 o; o.x = pk_bf16(a[0] * rn, a[1] * rn); o.y = pk_bf16(a[2] * rn, a[3] * rn); o.z = pk_bf16(a[4] * rn, a[5] * rn); o.w = pk_bf16(a[6] * rn, a[7] * rn);
        *(u32x4*)(rowp + (size_t)(i0 + i) * ld) = o;
        h0 = h1; h1 = h2; h2 = c3;
      }
    }
  }
}

__device__ void sg_item(const Params& p, int layer, int item, char* lds, bool st_en) {
  const int tid = tidx(), lane = tid & 63, wave = tid >> 6;
  const int g = item & 3, t0 = (item >> 2) * 128;
  bf16_t* Vt = (bf16_t*)lds;
  bf16_t* Ws = Vt + 128 * 136;
  const float* w = p.sg_w + ((size_t)(layer * 4 + g)) * 128 * 128;
  for (int i = tid; i < 128 * 32; i += NT) {
    const int t = i >> 5, s4 = (i & 31) * 4;
    f32x4 v = *(const f32x4*)(w + t * 128 + s4);
    u32x2 o; o.x = pk_bf16(s4 + 0 <= t ? v[0] : 0.f, s4 + 1 <= t ? v[1] : 0.f); o.y = pk_bf16(s4 + 2 <= t ? v[2] : 0.f, s4 + 3 <= t ? v[3] : 0.f);
    *(u32x2*)(Ws + t * 136 + s4) = o;
  }
  const float* lg = p.sg_ln_g + layer * 512; const float* lb = p.sg_ln_b + layer * 512;
  for (int tb8 = 0; tb8 < 16; tb8 += 8) {
  u32x4 rawv[8];
#pragma unroll
  for (int tt = 0; tt < 8; ++tt) rawv[tt] = *(const u32x4*)(p.SGUV + (size_t)(t0 + wave * 16 + tb8 + tt) * 1024 + 512 + lane * 8);
#pragma unroll
  for (int tt = 0; tt < 8; ++tt) {
    const int tok = wave * 16 + tb8 + tt;
    const u32x4 raw = rawv[tt];
    float x[8];
    x[0] = geluf_(bflo(raw.x)); x[1] = geluf_(bfhi(raw.x)); x[2] = geluf_(bflo(raw.y)); x[3] = geluf_(bfhi(raw.y));
    x[4] = geluf_(bflo(raw.z)); x[5] = geluf_(bfhi(raw.z)); x[6] = geluf_(bflo(raw.w)); x[7] = geluf_(bfhi(raw.w));
    float s = 0.f;
#pragma unroll
    for (int j = 0; j < 8; ++j) s += x[j];
    const float mu = wave_sum(s) * (1.f / 512.f);
    float q = 0.f;
#pragma unroll
    for (int j = 0; j < 8; ++j) { x[j] -= mu; q += x[j] * x[j]; }
    const float rstd = rsqrtf(wave_sum(q) * (1.f / 512.f) + 1e-5f);
    if ((lane >> 4) == g) {
#pragma unroll
      for (int j = 0; j < 8; ++j) {
        const int ch = lane * 8 + j, d = (lane & 15) * 8 + j;
        Vt[d * 136 + tok] = f2bf(x[j] * rstd * lg[ch] + lb[ch]);
      }
    }
  }
  }
  __syncthreads();
  const int K = ((wave * 16 + 15) / 32 + 1) * 32;
  const int tok = wave * 16 + (lane & 15);
  const float bias = p.sg_b[(size_t)(layer * 4 + g) * 128 + tok];
#pragma unroll
  for (int nt = 0; nt < 8; ++nt) {
    f32x4 acc = {0.f, 0.f, 0.f, 0.f};
    acc = mma16(Vt + nt * 16 * 136, 136, Ws + wave * 16 * 136, 136, K, acc, lane);
    const int ch = g * 128 + nt * 16 + (lane >> 4) * 4;
    bf16_t* up = p.SGUV + (size_t)(t0 + tok) * 1024 + ch;
    const u32x2 ur = *(const u32x2*)up;
    u32x2 o;
    o.x = pk_bf16(geluf_(bflo(ur.x)) * (acc[0] + bias), geluf_(bfhi(ur.x)) * (acc[1] + bias));
    o.y = pk_bf16(geluf_(bflo(ur.y)) * (acc[2] + bias), geluf_(bfhi(ur.y)) * (acc[3] + bias));
    if (st_en) *(u32x2*)up = o;
  }
  __syncthreads();
}

__device__ void fox_item(const Params& p, int layer, int item, char* lds, bool st_en) {
  const int tid = tidx(), lane = tid & 63, wave = tid >> 6;
  const int qb = item & 31, bh = item >> 5, b = bh >> 3, h = bh & 7;
  bf16_t* Ks = (bf16_t*)lds;
  bf16_t* Vt = Ks + 64 * 72;
  float* ck = (float*)(Vt + 64 * 72);
  const float LOG2E = 1.4426950408889634f;
  const float sl2 = 0.125f * LOG2E;
  const bf16_t* base = p.FOXQKV + (size_t)b * SEQL * 1536;
  const float* cb = p.cbuf + (size_t)bh * SEQL;
  const int q0 = qb * 128 + wave * 16;
  const int qi = q0 + (lane & 15);
  bf16x8 qf[2];
  qf[0] = *(const bf16x8*)(base + (size_t)qi * 1536 + h * 64 + (lane >> 4) * 8);
  qf[1] = *(const bf16x8*)(base + (size_t)qi * 1536 + h * 64 + 32 + (lane >> 4) * 8);
  const float cq = cb[qi] * LOG2E;
  f32x4 o[4];
#pragma unroll
  for (int i = 0; i < 4; ++i) o[i] = (f32x4){0.f, 0.f, 0.f, 0.f};
  float mrun = -INFINITY, lrun = 0.f;
  const int ntiles = (qb + 1) * 2;
  int jstart;
  {
    float* red = (float*)lds;
    float qs = 0.f;
#pragma unroll
    for (int i = 0; i < 2; ++i) {
      u32x4 w; __builtin_memcpy(&w, &qf[i], 16);
      qs += bflo(w.x) * bflo(w.x) + bfhi(w.x) * bfhi(w.x) + bflo(w.y) * bflo(w.y) + bfhi(w.y) * bfhi(w.y)
          + bflo(w.z) * bflo(w.z) + bfhi(w.z) * bfhi(w.z) + bflo(w.w) * bflo(w.w) + bfhi(w.w) * bfhi(w.w);
    }
    qs += __shfl_xor(qs, 16); qs += __shfl_xor(qs, 32);
#pragma unroll
    for (int o = 8; o >= 1; o >>= 1) qs = fmaxf(qs, __shfl_xor(qs, o));
    if (lane == 0) red[wave] = qs;
    __syncthreads();
    float qm = red[0];
#pragma unroll
    for (int w = 1; w < 8; ++w) qm = fmaxf(qm, red[w]);
    const float qkmax = sqrtf(qm) * ((const float*)(p.ctrl + 64))[bh] * sl2;
    const float thr = -152.f - 2.f * qkmax;
    const float cfirst = cb[qb * 128] * LOG2E;
    const bool live = (lane < ntiles) && (cfirst - cb[lane * 64 + 63] * LOG2E >= thr);
    const unsigned long long bal = __ballot(live);
    jstart = bal ? (int)__builtin_ctzll(bal) : 0;
    __syncthreads();
  }
  const int lkey = tid >> 3, lseg = (tid & 7) * 8;
  u32x4 kr = *(const u32x4*)(base + (size_t)(jstart * 64 + lkey) * 1536 + 512 + h * 64 + lseg);
  u32x4 vr = *(const u32x4*)(base + (size_t)(jstart * 64 + lkey) * 1536 + 1024 + h * 64 + lseg);
  float ckv = (tid < 64) ? cb[jstart * 64 + tid] * LOG2E : 0.f;
  for (int j = jstart; j < ntiles; ++j) {
    const int k0 = j * 64;
    __syncthreads();
    *(u32x4*)(Ks + lkey * 72 + lseg) = kr;
    {
      const int lks = lkey ^ (lseg & 56);
      Vt[(lseg + 0) * 72 + lks] = (bf16_t)(vr.x & 0xffff); Vt[(lseg + 1) * 72 + lks] = (bf16_t)(vr.x >> 16);
      Vt[(lseg + 2) * 72 + lks] = (bf16_t)(vr.y & 0xffff); Vt[(lseg + 3) * 72 + lks] = (bf16_t)(vr.y >> 16);
      Vt[(lseg + 4) * 72 + lks] = (bf16_t)(vr.z & 0xffff); Vt[(lseg + 5) * 72 + lks] = (bf16_t)(vr.z >> 16);
      Vt[(lseg + 6) * 72 + lks] = (bf16_t)(vr.w & 0xffff); Vt[(lseg + 7) * 72 + lks] = (bf16_t)(vr.w >> 16);
    }
    if (tid < 64) ck[tid] = ckv;
    if (j + 1 < ntiles) {
      kr = *(const u32x4*)(base + (size_t)(k0 + 64 + lkey) * 1536 + 512 + h * 64 + lseg);
      vr = *(const u32x4*)(base + (size_t)(k0 + 64 + lkey) * 1536 + 1024 + h * 64 + lseg);
      if (tid < 64) ckv = cb[k0 + 64 + tid] * LOG2E;
    }
    __syncthreads();
    if (k0 > q0 + 15) continue;
    f32x4 s[4];
#pragma unroll
    for (int kt = 0; kt < 4; ++kt) {
      const bf16_t* ka = Ks + (kt * 16 + (lane & 15)) * 72 + (lane >> 4) * 8;
      f32x4 a = {0.f, 0.f, 0.f, 0.f};
      a = __builtin_amdgcn_mfma_f32_16x16x32_bf16(*(const bf16x8*)ka, qf[0], a, 0, 0, 0);
      a = __builtin_amdgcn_mfma_f32_16x16x32_bf16(*(const bf16x8*)(ka + 32), qf[1], a, 0, 0, 0);
      s[kt] = a;
    }
    const bool diag = (k0 + 63 > q0);
    float mx = -INFINITY;
#pragma unroll
    for (int kt = 0; kt < 4; ++kt) {
      const f32x4 c4 = *(const f32x4*)(ck + kt * 16 + (lane >> 4) * 4);
#pragma unroll
      for (int r = 0; r < 4; ++r) {
        float v = s[kt][r] * sl2 + (cq - c4[r]);
        if (diag && (k0 + kt * 16 + (lane >> 4) * 4 + r > qi)) v = -INFINITY;
        s[kt][r] = v; mx = fmaxf(mx, v);
      }
    }
    mx = fmaxf(mx, __shfl_xor(mx, 16)); mx = fmaxf(mx, __shfl_xor(mx, 32));
    const float mnew = fmaxf(mrun, mx);
    const float alpha = __builtin_amdgcn_exp2f(mrun - mnew);
    mrun = mnew;
    float ps = 0.f;
#pragma unroll
    for (int kt = 0; kt < 4; ++kt)
#pragma unroll
      for (int r = 0; r < 4; ++r) { const float pv = __builtin_amdgcn_exp2f(s[kt][r] - mnew); s[kt][r] = pv; ps += pv; }
    lrun = lrun * alpha + ps;
#pragma unroll
    for (int i = 0; i < 4; ++i) o[i] = o[i] * alpha;
#pragma unroll
    for (int t2 = 0; t2 < 2; ++t2) {
      u32x4 pw; pw.x = pk_bf16(s[2 * t2][0], s[2 * t2][1]); pw.y = pk_bf16(s[2 * t2][2], s[2 * t2][3]);
      pw.z = pk_bf16(s[2 * t2 + 1][0], s[2 * t2 + 1][1]); pw.w = pk_bf16(s[2 * t2 + 1][2], s[2 * t2 + 1][3]);
      bf16x8 pf; __builtin_memcpy(&pf, &pw, 16);
#pragma unroll
      for (int dt = 0; dt < 4; ++dt) {
        const int vd = dt * 16 + (lane & 15), vsw = ((vd >> 3) & 7) << 3, vk = t2 * 32 + (lane >> 4) * 4;
        const bf16_t* vrow = Vt + vd * 72;
        u32x2 v0 = *(const u32x2*)(vrow + (vk ^ vsw)), v1 = *(const u32x2*)(vrow + ((vk + 16) ^ vsw));
        u32x4 vw; vw.x = v0.x; vw.y = v0.y; vw.z = v1.x; vw.w = v1.y;
        bf16x8 vf; __builtin_memcpy(&vf, &vw, 16);
        o[dt] = __builtin_amdgcn_mfma_f32_16x16x32_bf16(vf, pf, o[dt], 0, 0, 0);
      }
    }
  }
  lrun += __shfl_xor(lrun, 16); lrun += __shfl_xor(lrun, 32);
  const float inv = 1.f / lrun;
  bf16_t* op = p.FOXQKV + (size_t)(b * SEQL + qi) * 1536 + h * 64 + (lane >> 4) * 4;
#pragma unroll
  for (int dt = 0; dt < 4; ++dt) {
    u32x2 w; w.x = pk_bf16(o[dt][0] * inv, o[dt][1] * inv); w.y = pk_bf16(o[dt][2] * inv, o[dt][3] * inv);
    if (st_en) *(u32x2*)(op + dt * 16) = w;
  }
  __syncthreads();
}


__device__ void fox_item2(const Params& p, int layer, int item, char* lds, bool st_en) {
  const int tid = tidx(), lane = tid & 63, wave = tid >> 6;
  const int qb = item & 15, bh = item >> 4, b = bh >> 3, h = bh & 7;
  bf16_t* Ks = (bf16_t*)lds;
  bf16_t* Vt = Ks + 64 * 72;
  float* ck = (float*)(Vt + 64 * 72);
  const float LOG2E = 1.4426950408889634f;
  const float sl2 = 0.125f * LOG2E;
  const bf16_t* base = p.FOXQKV + (size_t)b * SEQL * 1536;
  const float* cb = p.cbuf + (size_t)bh * SEQL;
  int q0u[2], qi[2]; bf16x8 qf[2][2]; float cq[2];
  f32x4 o[2][4]; float mrun[2], lrun[2];
#pragma unroll
  for (int u = 0; u < 2; ++u) {
    q0u[u] = qb * 256 + wave * 32 + u * 16; qi[u] = q0u[u] + (lane & 15);
    qf[u][0] = *(const bf16x8*)(base + (size_t)qi[u] * 1536 + h * 64 + (lane >> 4) * 8);
    qf[u][1] = *(const bf16x8*)(base + (size_t)qi[u] * 1536 + h * 64 + 32 + (lane >> 4) * 8);
    cq[u] = cb[qi[u]] * LOG2E;
    mrun[u] = -INFINITY; lrun[u] = 0.f;
#pragma unroll
    for (int i = 0; i < 4; ++i) o[u][i] = (f32x4){0.f, 0.f, 0.f, 0.f};
  }
  const int ntiles = (qb + 1) * 4;
  int jstart;
  {
    float* red = (float*)lds;
    float qs = 0.f;
#pragma unroll
    for (int u = 0; u < 2; ++u) {
      float q1 = 0.f;
#pragma unroll
      for (int i = 0; i < 2; ++i) {
        u32x4 w; __builtin_memcpy(&w, &qf[u][i], 16);
        q1 += bflo(w.x) * bflo(w.x) + bfhi(w.x) * bfhi(w.x) + bflo(w.y) * bflo(w.y) + bfhi(w.y) * bfhi(w.y)
            + bflo(w.z) * bflo(w.z) + bfhi(w.z) * bfhi(w.z) + bflo(w.w) * bflo(w.w) + bfhi(w.w) * bfhi(w.w);
      }
      q1 += __shfl_xor(q1, 16); q1 += __shfl_xor(q1, 32);
      qs = fmaxf(qs, q1);
    }
#pragma unroll
    for (int o2 = 8; o2 >= 1; o2 >>= 1) qs = fmaxf(qs, __shfl_xor(qs, o2));
    if (lane == 0) red[wave] = qs;
    __syncthreads();
    float qm = red[0];
#pragma unroll
    for (int w = 1; w < 8; ++w) qm = fmaxf(qm, red[w]);
    const float qkmax = sqrtf(qm) * ((const float*)(p.ctrl + 64))[bh] * sl2;
    const float thr = -152.f - 2.f * qkmax;
    const float cfirst = cb[qb * 256] * LOG2E;
    const bool live = (lane < ntiles) && (cfirst - cb[lane * 64 + 63] * LOG2E >= thr);
    const unsigned long long bal = __ballot(live);
    jstart = bal ? (int)__builtin_ctzll(bal) : 0;
    __syncthreads();
  }
  const int lkey = tid >> 3, lseg = (tid & 7) * 8;
  u32x4 kr = *(const u32x4*)(base + (size_t)(jstart * 64 + lkey) * 1536 + 512 + h * 64 + lseg);
  u32x4 vr = *(const u32x4*)(base + (size_t)(jstart * 64 + lkey) * 1536 + 1024 + h * 64 + lseg);
  float ckv = (tid < 64) ? cb[jstart * 64 + tid] * LOG2E : 0.f;
  for (int j = jstart; j < ntiles; ++j) {
    const int k0 = j * 64;
    __syncthreads();
    *(u32x4*)(Ks + lkey * 72 + lseg) = kr;
    {
      const int lks = lkey ^ (lseg & 56);
      Vt[(lseg + 0) * 72 + lks] = (bf16_t)(vr.x & 0xffff); Vt[(lseg + 1) * 72 + lks] = (bf16_t)(vr.x >> 16);
      Vt[(lseg + 2) * 72 + lks] = (bf16_t)(vr.y & 0xffff); Vt[(lseg + 3) * 72 + lks] = (bf16_t)(vr.y >> 16);
      Vt[(lseg + 4) * 72 + lks] = (bf16_t)(vr.z & 0xffff); Vt[(lseg + 5) * 72 + lks] = (bf16_t)(vr.z >> 16);
      Vt[(lseg + 6) * 72 + lks] = (bf16_t)(vr.w & 0xffff); Vt[(lseg + 7) * 72 + lks] = (bf16_t)(vr.w >> 16);
    }
    if (tid < 64) ck[tid] = ckv;
    if (j + 1 < ntiles) {
      kr = *(const u32x4*)(base + (size_t)(k0 + 64 + lkey) * 1536 + 512 + h * 64 + lseg);
      vr = *(const u32x4*)(base + (size_t)(k0 + 64 + lkey) * 1536 + 1024 + h * 64 + lseg);
      if (tid < 64) ckv = cb[k0 + 64 + tid] * LOG2E;
    }
    __syncthreads();
    if (k0 > q0u[1] + 15) continue;
    f32x4 s[2][4];
#pragma unroll
    for (int kt = 0; kt < 4; ++kt) {
      const bf16_t* ka = Ks + (kt * 16 + (lane & 15)) * 72 + (lane >> 4) * 8;
      const bf16x8 k0f = *(const bf16x8*)ka, k1f = *(const bf16x8*)(ka + 32);
#pragma unroll
      for (int u = 0; u < 2; ++u) {
        f32x4 a = {0.f, 0.f, 0.f, 0.f};
        a = __builtin_amdgcn_mfma_f32_16x16x32_bf16(k0f, qf[u][0], a, 0, 0, 0);
        a = __builtin_amdgcn_mfma_f32_16x16x32_bf16(k1f, qf[u][1], a, 0, 0, 0);
        s[u][kt] = a;
      }
    }
    bf16x8 pf[2][2];
#pragma unroll
    for (int u = 0; u < 2; ++u) {
      const bool diag = (k0 + 63 > q0u[u]);
      float mx = -INFINITY;
#pragma unroll
      for (int kt = 0; kt < 4; ++kt) {
        const f32x4 c4 = *(const f32x4*)(ck + kt * 16 + (lane >> 4) * 4);
#pragma unroll
        for (int r = 0; r < 4; ++r) {
          float v = s[u][kt][r] * sl2 + (cq[u] - c4[r]);
          if (diag && (k0 + kt * 16 + (lane >> 4) * 4 + r > qi[u])) v = -INFINITY;
          s[u][kt][r] = v; mx = fmaxf(mx, v);
        }
      }
      mx = fmaxf(mx, __shfl_xor(mx, 16)); mx = fmaxf(mx, __shfl_xor(mx, 32));
      const float mnew = fmaxf(mrun[u], mx);
      const float alpha = __builtin_amdgcn_exp2f(mrun[u] - mnew);
      mrun[u] = mnew;
      float ps = 0.f;
#pragma unroll
      for (int kt = 0; kt < 4; ++kt)
#pragma unroll
        for (int r = 0; r < 4; ++r) { const float pv = __builtin_amdgcn_exp2f(s[u][kt][r] - mnew); s[u][kt][r] = pv; ps += pv; }
      lrun[u] = lrun[u] * alpha + ps;
#pragma unroll
      for (int i = 0; i < 4; ++i) o[u][i] = o[u][i] * alpha;
#pragma unroll
      for (int t2 = 0; t2 < 2; ++t2) {
        u32x4 pw; pw.x = pk_bf16(s[u][2 * t2][0], s[u][2 * t2][1]); pw.y = pk_bf16(s[u][2 * t2][2], s[u][2 * t2][3]);
        pw.z = pk_bf16(s[u][2 * t2 + 1][0], s[u][2 * t2 + 1][1]); pw.w = pk_bf16(s[u][2 * t2 + 1][2], s[u][2 * t2 + 1][3]);
        __builtin_memcpy(&pf[u][t2], &pw, 16);
      }
    }
#pragma unroll
    for (int t2 = 0; t2 < 2; ++t2)
#pragma unroll
      for (int dt = 0; dt < 4; ++dt) {
        const int vd = dt * 16 + (lane & 15), vsw = ((vd >> 3) & 7) << 3, vk = t2 * 32 + (lane >> 4) * 4;
        const bf16_t* vrow = Vt + vd * 72;
        u32x2 v0 = *(const u32x2*)(vrow + (vk ^ vsw)), v1 = *(const u32x2*)(vrow + ((vk + 16) ^ vsw));
        u32x4 vw; vw.x = v0.x; vw.y = v0.y; vw.z = v1.x; vw.w = v1.y;
        bf16x8 vf; __builtin_memcpy(&vf, &vw, 16);
#pragma unroll
        for (int u = 0; u < 2; ++u) o[u][dt] = __builtin_amdgcn_mfma_f32_16x16x32_bf16(vf, pf[u][t2], o[u][dt], 0, 0, 0);
      }
  }
#pragma unroll
  for (int u = 0; u < 2; ++u) {
    float l = lrun[u];
    l += __shfl_xor(l, 16); l += __shfl_xor(l, 32);
    const float inv = 1.f / l;
    bf16_t* op = p.FOXQKV + (size_t)(b * SEQL + qi[u]) * 1536 + h * 64 + (lane >> 4) * 4;
#pragma unroll
    for (int dt = 0; dt < 4; ++dt) {
      u32x2 w; w.x = pk_bf16(o[u][dt][0] * inv, o[u][dt][1] * inv); w.y = pk_bf16(o[u][dt][2] * inv, o[u][dt][3] * inv);
      if (st_en) *(u32x2*)(op + dt * 16) = w;
    }
  }
  __syncthreads();
}

__device__ void ssd_item(const Params& p, int layer, int item, char* lds, bool st_en) {
  const int tid = tidx(), lane = tid & 63, wave = tid >> 6;
  const int b = item >> 3, h = item & 7, g = h >> 2;
  bf16_t* Cs = (bf16_t*)(lds + opq(0));
  bf16_t* Bs = (bf16_t*)(lds + opq(17408));
  bf16_t* XT = (bf16_t*)(lds + opq(34816));
  bf16_t* XdT = (bf16_t*)(lds + opq(44032));
  bf16_t* Xr = (bf16_t*)(lds + opq(53248));
  bf16_t* CBm = (bf16_t*)(lds + opq(62464));
  bf16_t* Pb = (bf16_t*)(lds + opq(71680));
  float* acs = (float*)(lds + opq(89088));
  float* dtv = acs + 64;
  float* part = dtv + 64;
  const float* cw = p.ssd_conv_w + (size_t)layer * 4 * 1024;
  const float* cbias = p.ssd_conv_b + (size_t)layer * 1024;
  const float dtb = p.ssd_dt_bias[layer * 8 + h], aneg = -__expf(p.ssd_a_log[layer * 8 + h]), dsk = p.ssd_d[layer * 8 + h];
  const float* nw = p.ssd_norm_w + layer * 512 + h * 64;
  const int lt = wave >> 1, pt0 = (wave & 1) * 2;
  f32x4 st[4];
#pragma unroll
  for (int i = 0; i < 4; ++i) st[i] = (f32x4){0.f, 0.f, 0.f, 0.f};
  for (int i = tid; i < 64 * 136; i += NT) Pb[i] = 0;
  u32x4 xc, bc[2], ccv[2]; u32x2 zpre[2]; float apre = 0.f, dpre = 0.f;
  auto prefetch = [&](int step) {
    const size_t tbn = (size_t)b * SEQL + step * 64;
    const bf16_t* rp = p.XBC + tbn * 1024;
    xc = *(const u32x4*)(rp + (size_t)(tid >> 3) * 1024 + h * 64 + (tid & 7) * 8);
#pragma unroll
    for (int c = 0; c < 2; ++c) {
      const int id = tid + c * 512, s = id >> 4, col = (id & 15) * 8;
      bc[c] = *(const u32x4*)(rp + (size_t)s * 1024 + 512 + g * 128 + col);
      ccv[c] = *(const u32x4*)(rp + (size_t)s * 1024 + 768 + g * 128 + col);
    }
#pragma unroll
    for (int i = 0; i < 2; ++i)
      zpre[i] = *(const u32x2*)(p.Z + (tbn + lt * 16 + (lane & 15)) * 512 + h * 64 + (pt0 + i) * 16 + (lane >> 4) * 4);
    if (tid < 64) { apre = p.small[(tbn + tid) * 32 + 24 + h]; dpre = p.small[(tbn + tid) * 32 + h]; }
  };
  f32x4 nvh[2];
#pragma unroll
  for (int i = 0; i < 2; ++i) nvh[i] = *(const f32x4*)(nw + (pt0 + i) * 16 + (lane >> 4) * 4);
  prefetch(0);
  for (int step = 0; step < 64; ++step) {
    const int l0 = step * 64;
    const size_t tb = (size_t)b * SEQL + l0;
    __syncthreads();
    if (wave == 0) { acs[lane] = apre; dtv[lane] = dpre; }
    const u32x4 xc_c = xc, bc0 = bc[0], bc1 = bc[1], cc0 = ccv[0], cc1 = ccv[1];
    const u32x2 zc0 = zpre[0], zc1 = zpre[1];
    if (step + 1 < 64) prefetch(step + 1);
    __builtin_amdgcn_sched_barrier(0);
    __syncthreads();
    {
      const float alast = acs[63];
      const int s = tid >> 3, col = (tid & 7) * 8;
      const float dt = dtv[s], dec = __expf(alast - acs[s]);
      *(u32x4*)(Xr + s * 72 + col) = xc_c;
      float a[8] = {bflo(xc_c.x), bfhi(xc_c.x), bflo(xc_c.y), bfhi(xc_c.y), bflo(xc_c.z), bfhi(xc_c.z), bflo(xc_c.w), bfhi(xc_c.w)};
#pragma unroll
      for (int j = 0; j < 8; ++j) { const float xd = a[j] * dt; XT[(col + j) * 72 + s] = f2bf(xd); XdT[(col + j) * 72 + s] = f2bf(xd * dec); }
#pragma unroll
      for (int c = 0; c < 2; ++c) {
        const int id = tid + c * 512, s2 = id >> 4, col2 = (id & 15) * 8;
        *(u32x4*)(Bs + s2 * 136 + col2) = c ? bc1 : bc0;
        *(u32x4*)(Cs + s2 * 136 + col2) = c ? cc1 : cc0;
      }
    }
    __syncthreads();
#pragma unroll
    for (int i = 0; i < 2; ++i) {
      const int id = wave * 2 + i, lt2 = id >> 2, st2 = id & 3;
      f32x4 a = {0.f, 0.f, 0.f, 0.f};
      a = mma16(Bs + st2 * 16 * 136, 136, Cs + lt2 * 16 * 136, 136, 128, a, lane);
      const int l = lt2 * 16 + (lane & 15), s0 = st2 * 16 + (lane >> 4) * 4;
      const float al = acs[l];
      float v[4];
#pragma unroll
      for (int r = 0; r < 4; ++r) v[r] = (s0 + r <= l) ? a[r] * __expf(al - acs[s0 + r]) : 0.f;
      u32x2 w; w.x = pk_bf16(v[0], v[1]); w.y = pk_bf16(v[2], v[3]);
      *(u32x2*)(CBm + l * 72 + s0) = w;
    }
    f32x4 yo[2];
#pragma unroll
    for (int i = 0; i < 2; ++i) {
      f32x4 a = {0.f, 0.f, 0.f, 0.f};
      yo[i] = mma16(Pb + (pt0 + i) * 16 * 136, 136, Cs + lt * 16 * 136, 136, 128, a, lane);
    }
    __syncthreads();
    {
      const int l = lt * 16 + (lane & 15);
      const float el = __expf(acs[l]);
      const size_t tok = tb + l;
      float ssq = 0.f;
#pragma unroll
      for (int i = 0; i < 2; ++i) {
        f32x4 a = {0.f, 0.f, 0.f, 0.f};
        a = mma16(XT + (pt0 + i) * 16 * 72, 72, CBm + lt * 16 * 72, 72, 64, a, lane);
        const int pp = (pt0 + i) * 16 + (lane >> 4) * 4;
        const u32x2 xr = *(const u32x2*)(Xr + l * 72 + pp);
        bf16_t* zp = p.Z + tok * 512 + h * 64 + pp;
        const u32x2 zr = i ? zc1 : zc0;
        const f32x4 nv = nvh[i];
        float y[4];
        y[0] = (a[0] + yo[i][0] * el + dsk * bflo(xr.x)) * siluf_(bflo(zr.x));
        y[1] = (a[1] + yo[i][1] * el + dsk * bfhi(xr.x)) * siluf_(bfhi(zr.x));
        y[2] = (a[2] + yo[i][2] * el + dsk * bflo(xr.y)) * siluf_(bflo(zr.y));
        y[3] = (a[3] + yo[i][3] * el + dsk * bfhi(xr.y)) * siluf_(bfhi(zr.y));
        ssq += (y[0] * y[0] + y[1] * y[1]) + (y[2] * y[2] + y[3] * y[3]);
        u32x2 w; w.x = pk_bf16(y[0] * nv[0], y[1] * nv[1]); w.y = pk_bf16(y[2] * nv[2], y[3] * nv[3]);
        if (st_en) *(u32x2*)zp = w;
      }
      ssq += __shfl_xor(ssq, 16); ssq += __shfl_xor(ssq, 32);
      if (lane < 16) part[(wave & 1) * 64 + l] = ssq;
    }
    {
      const float ea = __expf(acs[63]);
      const int n = wave * 16 + (lane & 15);
      bf16x8 bfr[2];
#pragma unroll
      for (int ks = 0; ks < 2; ++ks) {
        u32x4 w;
        const bf16_t* bp = Bs + (ks * 32 + (lane >> 4) * 8) * 136 + n;
        w.x = (unsigned)bp[0] | ((unsigned)bp[136] << 16); w.y = (unsigned)bp[2 * 136] | ((unsigned)bp[3 * 136] << 16);
        w.z = (unsigned)bp[4 * 136] | ((unsigned)bp[5 * 136] << 16); w.w = (unsigned)bp[6 * 136] | ((unsigned)bp[7 * 136] << 16);
        __builtin_memcpy(&bfr[ks], &w, 16);
      }
#pragma unroll
      for (int i = 0; i < 4; ++i) {
        f32x4 a = st[i] * ea;
        const bf16_t* ap = XdT + (i * 16 + (lane & 15)) * 72 + (lane >> 4) * 8;
        a = __builtin_amdgcn_mfma_f32_16x16x32_bf16(*(const bf16x8*)ap, bfr[0], a, 0, 0, 0);
        a = __builtin_amdgcn_mfma_f32_16x16x32_bf16(*(const bf16x8*)(ap + 32), bfr[1], a, 0, 0, 0);
        st[i] = a;
#pragma unroll
        for (int r = 0; r < 4; ++r) Pb[(i * 16 + (lane >> 4) * 4 + r) * 136 + n] = f2bf(a[r]);
      }
    }
    __syncthreads();
    if (tid < 64 && st_en) p.ssqp[(size_t)h * MTOK + tb + tid] = part[tid] + part[64 + tid];
  }
  __syncthreads();
}

__device__ __forceinline__ bf16_t* dn_Wg(const Params& p) { return (bf16_t*)p.hf; }
__device__ __forceinline__ float* dn_Ug(const Params& p) { return (float*)((char*)p.hf + ((size_t)32 << 20)); }
__device__ __forceinline__ bf16_t* dn_QKg(const Params& p) { return (bf16_t*)((char*)p.hf + ((size_t)96 << 20)); }

__device__ void dn_prep_item(const Params& p, int layer, int item, char* lds) {
  const int tid = tidx(), lane = tid & 63, wave = tid >> 6;
  const int step = item & 63, bh = item >> 6, b = bh >> 2, h = bh & 3;
  bf16_t* Kn = (bf16_t*)(lds + opq(0));
  bf16_t* Qn = (bf16_t*)(lds + opq(17408));
  bf16_t* Wm = (bf16_t*)(lds + opq(34816));
  bf16_t* QK = (bf16_t*)(lds + opq(52224));
  float* At = (float*)(lds + opq(61440));
  float* VU = (float*)(lds + opq(79872));
  float* gcs = (float*)(lds + opq(148480));
  float* bet = gcs + 64;
  const size_t tb = (size_t)b * SEQL + step * 64;
  __syncthreads();
  if (wave == 0) { gcs[lane] = p.small[(tb + lane) * 32 + 12 + h]; bet[lane] = p.small[(tb + lane) * 32 + 8 + h]; }
  u32x4 qv[2], kv[2], vv[2];
  {
    const bf16_t* rp = p.DNQKV + tb * 1536 + h * 128;
#pragma unroll
    for (int c = 0; c < 2; ++c) {
      const int id = tid + c * 512, s = id >> 4, dd = (id & 15) * 8;
      qv[c] = *(const u32x4*)(rp + (size_t)s * 1536 + dd);
      kv[c] = *(const u32x4*)(rp + (size_t)s * 1536 + 512 + dd);
      vv[c] = *(const u32x4*)(rp + (size_t)s * 1536 + 1024 + dd);
    }
  }
  __syncthreads();
#pragma unroll
  for (int c = 0; c < 2; ++c) {
    const int id = tid + c * 512, s = id >> 4, dd = (id & 15) * 8;
    *(u32x4*)(Qn + s * 136 + dd) = qv[c];
    *(u32x4*)(Kn + s * 136 + dd) = kv[c];
    const float be = bet[s];
    f32x4 v0 = {bflo(vv[c].x) * be, bfhi(vv[c].x) * be, bflo(vv[c].y) * be, bfhi(vv[c].y) * be};
    f32x4 v1 = {bflo(vv[c].z) * be, bfhi(vv[c].z) * be, bflo(vv[c].w) * be, bfhi(vv[c].w) * be};
    *(f32x4*)(VU + s * 132 + dd) = v0; *(f32x4*)(VU + s * 132 + dd + 4) = v1;
  }
  __syncthreads();
#pragma unroll
  for (int t = 0; t < 2; ++t) {
    const int id = wave * 2 + t, it = id >> 2, jt = id & 3;
    const int i = it * 16 + (lane & 15), j0 = jt * 16 + (lane >> 4) * 4;
    const float gi = gcs[i], bi = bet[i];
    f32x4 a = {0.f, 0.f, 0.f, 0.f};
    a = mma16(Kn + jt * 16 * 136, 136, Kn + it * 16 * 136, 136, 128, a, lane);
#pragma unroll
    for (int r = 0; r < 4; ++r) At[(j0 + r) * 64 + i] = (j0 + r < i) ? bi * a[r] * __expf(gi - gcs[j0 + r]) : 0.f;
    f32x4 q = {0.f, 0.f, 0.f, 0.f};
    q = mma16(Kn + jt * 16 * 136, 136, Qn + it * 16 * 136, 136, 128, q, lane);
    float qq[4];
#pragma unroll
    for (int r = 0; r < 4; ++r) qq[r] = (j0 + r <= i) ? q[r] * __expf(gi - gcs[j0 + r]) : 0.f;
    u32x2 w; w.x = pk_bf16(qq[0], qq[1]); w.y = pk_bf16(qq[2], qq[3]);
    *(u32x2*)(QK + i * 72 + j0) = w;
  }
  __syncthreads();
  if (tid < 256) {
    float xs[64];
    if (tid < 128) {
#pragma unroll
      for (int s = 0; s < 64; ++s) xs[s] = bf2f(Kn[s * 136 + tid]) * bet[s] * __expf(gcs[s]);
    } else {
#pragma unroll
      for (int s = 0; s < 64; ++s) xs[s] = VU[s * 132 + (tid - 128)];
    }
#pragma unroll
    for (int j = 0; j < 63; ++j) {
      const float xj = xs[j];
#pragma unroll
      for (int i = j + 1; i < 64; ++i) xs[i] -= At[j * 64 + i] * xj;
      if ((j & 3) == 3) asm volatile("" ::: "memory");
    }
    if (tid < 128) {
#pragma unroll
      for (int s = 0; s < 64; ++s) Wm[s * 136 + tid] = f2bf(xs[s]);
    } else {
#pragma unroll
      for (int s = 0; s < 64; ++s) VU[s * 132 + (tid - 128)] = xs[s];
    }
  }
  __syncthreads();
  {
    bf16_t* Wg = dn_Wg(p) + tb * 512 + h * 128;
    float* Ug = dn_Ug(p) + tb * 512 + h * 128;
    bf16_t* QKg = dn_QKg(p) + ((tb >> 6) * 4 + h) * 4096;
#pragma unroll
    for (int c = 0; c < 2; ++c) {
      const int id = tid + c * 512, s = id >> 4, dd = (id & 15) * 8;
      *(u32x4*)(Wg + (size_t)s * 512 + dd) = *(const u32x4*)(Wm + s * 136 + dd);
    }
#pragma unroll
    for (int c = 0; c < 4; ++c) {
      const int id = tid + c * 512, s = id >> 5, e4 = (id & 31) * 4;
      *(f32x4*)(Ug + (size_t)s * 512 + e4) = *(const f32x4*)(VU + s * 132 + e4);
    }
    *(u32x4*)(QKg + (tid >> 3) * 64 + (tid & 7) * 8) = *(const u32x4*)(QK + (tid >> 3) * 72 + (tid & 7) * 8);
  }
}

__device__ void dn_scan_item(const Params& p, int layer, int item, char* lds, bool st_en) {
  const int tid = tidx(), lane = tid & 63, wave = tid >> 6;
  const int b = item >> 2, h = item & 3;
  bf16_t* Kn = (bf16_t*)(lds + opq(0));
  bf16_t* Qn = (bf16_t*)(lds + opq(17408));
  bf16_t* Wm = (bf16_t*)(lds + opq(34816));
  bf16_t* QK = (bf16_t*)(lds + opq(52224));
  bf16_t* VnT = (bf16_t*)(lds + opq(61440));
  float* VU = (float*)(lds + opq(79872));
  bf16_t* ST = (bf16_t*)(lds + opq(113664));
  float* gcs = (float*)(lds + opq(148480));
  float* Of = (float*)Qn;
  float nwv[8];
#pragma unroll
  for (int j = 0; j < 8; ++j) nwv[j] = p.dn_norm_w[layer * 128 + (lane & 15) * 8 + j];
  f32x4 S[8];
#pragma unroll
  for (int i = 0; i < 8; ++i) S[i] = (f32x4){0.f, 0.f, 0.f, 0.f};
  for (int i = tid; i < 128 * 136; i += NT) ST[i] = 0;
  u32x4 wv[2], qv[2], kv[2], qkv; f32x4 uv[4]; float gv = 0.f; u32x4 gpre[2];
  auto prefetch = [&](int step) {
    const size_t tb = (size_t)b * SEQL + step * 64;
    const bf16_t* rp = p.DNQKV + tb * 1536 + h * 128;
    const bf16_t* Wg = dn_Wg(p) + tb * 512 + h * 128;
    const float* Ug = dn_Ug(p) + tb * 512 + h * 128;
    const bf16_t* QKg = dn_QKg(p) + ((tb >> 6) * 4 + h) * 4096;
#pragma unroll
    for (int c = 0; c < 2; ++c) {
      const int id = tid + c * 512, s = id >> 4, dd = (id & 15) * 8;
      qv[c] = *(const u32x4*)(rp + (size_t)s * 1536 + dd);
      kv[c] = *(const u32x4*)(rp + (size_t)s * 1536 + 512 + dd);
      wv[c] = *(const u32x4*)(Wg + (size_t)s * 512 + dd);
    }
#pragma unroll
    for (int c = 0; c < 4; ++c) {
      const int id = tid + c * 512, s = id >> 5, e4 = (id & 31) * 4;
      uv[c] = *(const f32x4*)(Ug + (size_t)s * 512 + e4);
    }
    qkv = *(const u32x4*)(QKg + (tid >> 3) * 64 + (tid & 7) * 8);
    if (tid < 64) gv = p.small[(tb + tid) * 32 + 12 + h];
#pragma unroll
    for (int tt = 0; tt < 2; ++tt) gpre[tt] = *(const u32x4*)(p.DNG + (tb + wave * 8 + tt * 4 + (lane >> 4)) * 512 + h * 128 + (lane & 15) * 8);
  };
  prefetch(0);
  for (int step = 0; step < 64; ++step) {
    const size_t tb = (size_t)b * SEQL + step * 64;
    __syncthreads();
#pragma unroll
    for (int c = 0; c < 2; ++c) {
      const int id = tid + c * 512, s = id >> 4, dd = (id & 15) * 8;
      *(u32x4*)(Qn + s * 136 + dd) = qv[c];
      *(u32x4*)(Kn + s * 136 + dd) = kv[c];
      *(u32x4*)(Wm + s * 136 + dd) = wv[c];
    }
#pragma unroll
    for (int c = 0; c < 4; ++c) {
      const int id = tid + c * 512, s = id >> 5, e4 = (id & 31) * 4;
      *(f32x4*)(VU + s * 132 + e4) = uv[c];
    }
    *(u32x4*)(QK + (tid >> 3) * 72 + (tid & 7) * 8) = qkv;
    if (tid < 64) { const float glast = __shfl(gv, 63); gcs[tid] = gv; gcs[64 + tid] = __expf(glast - gv); gcs[128 + tid] = __expf(gv); }
    u32x4 gcur[2];
#pragma unroll
    for (int tt = 0; tt < 2; ++tt) gcur[tt] = gpre[tt];
    if (step + 1 < 64) prefetch(step + 1);
    __builtin_amdgcn_sched_barrier(0);
    __syncthreads();
    f32x4 o1[4];
    {
      const int stl = wave >> 1;
      f32x4 av[4];
#pragma unroll
      for (int i = 0; i < 4; ++i) { av[i] = (f32x4){0.f, 0.f, 0.f, 0.f}; o1[i] = (f32x4){0.f, 0.f, 0.f, 0.f}; }
      const bf16_t* wrow = Wm + (stl * 16 + (lane & 15)) * 136 + (lane >> 4) * 8;
      const bf16_t* qrow = Qn + (stl * 16 + (lane & 15)) * 136 + (lane >> 4) * 8;
#pragma unroll
      for (int ks = 0; ks < 4; ++ks) {
        const bf16x8 wf = *(const bf16x8*)(wrow + ks * 32), qf2 = *(const bf16x8*)(qrow + ks * 32);
#pragma unroll
        for (int i = 0; i < 4; ++i) {
          const int et = (wave & 1) * 4 + i;
          const bf16x8 sf = *(const bf16x8*)(ST + (et * 16 + (lane & 15)) * 136 + (lane >> 4) * 8 + ks * 32);
          av[i] = __builtin_amdgcn_mfma_f32_16x16x32_bf16(wf, sf, av[i], 0, 0, 0);
          o1[i] = __builtin_amdgcn_mfma_f32_16x16x32_bf16(sf, qf2, o1[i], 0, 0, 0);
        }
      }
      const float eg = gcs[128 + stl * 16 + (lane & 15)];
#pragma unroll
      for (int i = 0; i < 4; ++i) {
        const int et = (wave & 1) * 4 + i;
        const int s0 = stl * 16 + (lane >> 4) * 4, e = et * 16 + (lane & 15);
        float vn[4];
#pragma unroll
        for (int r = 0; r < 4; ++r) vn[r] = VU[(s0 + r) * 132 + e] - av[i][r];
        u32x2 w; w.x = pk_bf16(vn[0], vn[1]); w.y = pk_bf16(vn[2], vn[3]);
        *(u32x2*)(VnT + e * 72 + s0) = w;
        o1[i] = o1[i] * eg;
      }
    }
    __syncthreads();
    {
      const int stl = wave >> 1;
#pragma unroll
      for (int i = 0; i < 4; ++i) {
        const int et = (wave & 1) * 4 + i;
        f32x4 a = mma16(VnT + et * 16 * 72, 72, QK + stl * 16 * 72, 72, 64, o1[i], lane);
        const int s = stl * 16 + (lane & 15), e0 = et * 16 + (lane >> 4) * 4;
        *(f32x4*)(Of + s * 132 + e0) = a;
      }
      const float gl = gcs[63], egl = __expf(gl);
      bf16x8 kf[2];
#pragma unroll
      for (int ks = 0; ks < 2; ++ks) {
        const int d = wave * 16 + (lane & 15), s0 = ks * 32 + (lane >> 4) * 8;
        float kk[8];
#pragma unroll
        for (int j = 0; j < 8; ++j) kk[j] = bf2f(Kn[(s0 + j) * 136 + d]) * gcs[64 + s0 + j];
        u32x4 w; w.x = pk_bf16(kk[0], kk[1]); w.y = pk_bf16(kk[2], kk[3]); w.z = pk_bf16(kk[4], kk[5]); w.w = pk_bf16(kk[6], kk[7]);
        __builtin_memcpy(&kf[ks], &w, 16);
      }
#pragma unroll
      for (int et = 0; et < 8; ++et) {
        f32x4 a = S[et] * egl;
        const bf16_t* vp = VnT + (et * 16 + (lane & 15)) * 72 + (lane >> 4) * 8;
        a = __builtin_amdgcn_mfma_f32_16x16x32_bf16(kf[0], *(const bf16x8*)vp, a, 0, 0, 0);
        a = __builtin_amdgcn_mfma_f32_16x16x32_bf16(kf[1], *(const bf16x8*)(vp + 32), a, 0, 0, 0);
        S[et] = a;
      }
    }
    __syncthreads();
#pragma unroll
    for (int et = 0; et < 8; ++et) {
      u32x2 w; w.x = pk_bf16(S[et][0], S[et][1]); w.y = pk_bf16(S[et][2], S[et][3]);
      *(u32x2*)(ST + (et * 16 + (lane & 15)) * 136 + wave * 16 + (lane >> 4) * 4) = w;
    }
#pragma unroll
    for (int tt = 0; tt < 2; ++tt) {
      const int s = wave * 8 + tt * 4 + (lane >> 4), e0 = (lane & 15) * 8;
      const f32x4 oa = *(const f32x4*)(Of + s * 132 + e0), ob = *(const f32x4*)(Of + s * 132 + e0 + 4);
      float ss = (oa[0] * oa[0] + oa[1] * oa[1]) + (oa[2] * oa[2] + oa[3] * oa[3]) + (ob[0] * ob[0] + ob[1] * ob[1]) + (ob[2] * ob[2] + ob[3] * ob[3]);
      ss += __shfl_xor(ss, 1); ss += __shfl_xor(ss, 2); ss += __shfl_xor(ss, 4); ss += __shfl_xor(ss, 8);
      const float rn = rsqrtf(ss * (1.f / 128.f) + 1e-6f);
      const u32x4 gr = gcur[tt];
      u32x4 w;
      w.x = pk_bf16(oa[0] * rn * nwv[0] * siluf_(bflo(gr.x)), oa[1] * rn * nwv[1] * siluf_(bfhi(gr.x)));
      w.y = pk_bf16(oa[2] * rn * nwv[2] * siluf_(bflo(gr.y)), oa[3] * rn * nwv[3] * siluf_(bfhi(gr.y)));
      w.z = pk_bf16(ob[0] * rn * nwv[4] * siluf_(bflo(gr.z)), ob[1] * rn * nwv[5] * siluf_(bfhi(gr.z)));
      w.w = pk_bf16(ob[2] * rn * nwv[6] * siluf_(bflo(gr.w)), ob[3] * rn * nwv[7] * siluf_(bfhi(gr.w)));
      if (st_en) *(u32x4*)(p.DNG + (tb + s) * 512 + h * 128 + e0) = w;
    }
  }
  __syncthreads();
}

__device__ void mixer_phase1(const Params& p, int layer, char* lds) {
  for (int it = bidx(); it < 2048; it += (int)gridDim.x) dn_prep_item(p, layer, it, lds);
  __syncthreads();
}
__device__ void mixer_phase2(const Params& p, int layer, char* lds, int* s_item) {
  constexpr int N_SEQ = 96, N_FOX = 1024, N_SG = 1024, TOTAL = N_SEQ + N_FOX + N_SG;
  unsigned* ctr = p.ctrl + layer;
  for (;;) {
    if (tidx() == 0) *s_item = (int)atomicAdd(ctr, 1u);
    __syncthreads();
    const int it = *s_item;
    __syncthreads();
    if (it >= TOTAL) break;
    if (it < 32) dn_scan_item(p, layer, it, lds, true);
    else if (it < N_SEQ) ssd_item(p, layer, it - 32, lds, true);
    else if (it < N_SEQ + N_FOX) { const int u = it - N_SEQ; fox_item2(p, layer, ((u & 63) << 4) | (15 - (u >> 6)), lds, true); }
    else sg_item(p, layer, it - N_SEQ - N_FOX, lds, true);
  }
}

__device__ void merge_phase(const Params& p, int layer, PG8_LAS unsigned char* lds3) {
  const int lane = tidx() & 63, wave = tidx() >> 6, wm = wave >> 2, wn = wave & 3;
  bf16_t* merged = p.XBC;
  for (int t = bidx(); t < 256 * 4; t += gridDim.x) {
    const int mt = t >> 2, nt = t & 3, m0 = mt * 128, n0 = nt * 256;
    f32x16 mg[2][2];
    zero_acc<2, 2>(mg);
#pragma unroll 1
    for (int br = 0; br < 4; ++br) {
      unsigned gp[2][2][8];
      {
        f32x16 acc[2][2];
        zero_acc<2, 2>(acc);
        gemm_mainloop_dma<2, 2, true>(p.hb + (size_t)m0 * DM, DM, p.WinT + (size_t)(NPROJ + br * 1024 + n0) * DM, DM, DM, lds3, acc);
        const float* gb = p.gate_b + (size_t)(layer * 4 + br) * 1024 + n0;
#pragma unroll
        for (int ni = 0; ni < 2; ++ni)
#pragma unroll
          for (int q = 0; q < 4; ++q) {
            const f32x4 bv = *(const f32x4*)(gb + ni * 128 + wn * 32 + q * 8 + (lane >> 5) * 4);
#pragma unroll
            for (int mi = 0; mi < 2; ++mi) {
              gp[ni][mi][q * 2 + 0] = pk_bf16(sigmoidf_(acc[mi][ni][q * 4 + 0] + bv[0]), sigmoidf_(acc[mi][ni][q * 4 + 1] + bv[1]));
              gp[ni][mi][q * 2 + 1] = pk_bf16(sigmoidf_(acc[mi][ni][q * 4 + 2] + bv[2]), sigmoidf_(acc[mi][ni][q * 4 + 3] + bv[3]));
            }
          }
      }
      const bf16_t* ya; int lda;
      if (br == 0) { ya = p.Z; lda = 512; }
      else if (br == 1) { ya = p.DNG; lda = 512; }
      else if (br == 2) { ya = p.SGUV; lda = 1024; }
      else { ya = p.FOXQKV; lda = 1536; }
      float rs[2] = {1.f, 1.f};
      if (br == 0) {
#pragma unroll
        for (int mi = 0; mi < 2; ++mi) {
          const int m = m0 + wm * 64 + mi * 32 + (lane & 31);
          float ss = 0.f;
#pragma unroll
          for (int hh = 0; hh < 8; ++hh) ss += p.ssqp[(size_t)hh * MTOK + m];
          rs[mi] = rsqrtf(ss * (1.f / 512.f) + 1e-6f);
        }
      }
#pragma unroll
      for (int half = 0; half < 2; ++half) {
        f32x16 acc[2][1];
        zero_acc<2, 1>(acc);
        gemm_mainloop_dma128<2, 1>(ya + (size_t)m0 * lda, lda, p.WbT + ((size_t)br * 1024 + n0 + half * 128) * 512, 512, 512, lds3, acc);
#pragma unroll
        for (int mi = 0; mi < 2; ++mi)
#pragma unroll
          for (int q = 0; q < 4; ++q) {
            mg[half][mi][q * 4 + 0] += bflo(gp[half][mi][q * 2 + 0]) * acc[mi][0][q * 4 + 0] * rs[mi];
            mg[half][mi][q * 4 + 1] += bfhi(gp[half][mi][q * 2 + 0]) * acc[mi][0][q * 4 + 1] * rs[mi];
            mg[half][mi][q * 4 + 2] += bflo(gp[half][mi][q * 2 + 1]) * acc[mi][0][q * 4 + 2] * rs[mi];
            mg[half][mi][q * 4 + 3] += bfhi(gp[half][mi][q * 2 + 1]) * acc[mi][0][q * 4 + 3] * rs[mi];
          }
      }
    }
#pragma unroll
    for (int half = 0; half < 2; ++half)
#pragma unroll
      for (int mi = 0; mi < 2; ++mi) {
        const int m = m0 + wm * 64 + mi * 32 + (lane & 31);
#pragma unroll
        for (int q = 0; q < 4; ++q) {
          const int n = n0 + half * 128 + wn * 32 + q * 8 + (lane >> 5) * 4;
          u32x2 w; w.x = pk_bf16(mg[half][mi][q * 4 + 0], mg[half][mi][q * 4 + 1]); w.y = pk_bf16(mg[half][mi][q * 4 + 2], mg[half][mi][q * 4 + 3]);
          *(u32x2*)(merged + (size_t)m * DM + n) = w;
        }
      }
  }
}

__device__ void resid_gemm_phase(const Params& p, const bf16_t* A, int K, const bf16_t* Bt, char* lds) {
  const int lane = tidx() & 63, wave = tidx() >> 6, wm = wave >> 2, wn = wave & 3;
  for (int t = bidx(); t < 128 * 4; t += gridDim.x) {
    const int mt = t >> 2, nt = t & 3;
    f32x16 acc[4][2];
    zero_acc<4, 2>(acc);
    gemm_mainloop<4, 2>(A + (size_t)mt * 256 * K, K, Bt + (size_t)nt * 256 * K, K, K, lds, acc);
#pragma unroll
    for (int mi = 0; mi < 4; ++mi) {
      const int m = mt * 256 + wm * 128 + mi * 32 + (lane & 31);
#pragma unroll
      for (int ni = 0; ni < 2; ++ni)
#pragma unroll
        for (int q = 0; q < 4; ++q) {
          const int n = nt * 256 + wn * 64 + ni * 32 + q * 8 + (lane >> 5) * 4;
          float* hp = p.hf + (size_t)m * DM + n;
          f32x4 v = *(const f32x4*)hp;
          v[0] = ALPHA * v[0] + acc[mi][ni][q * 4 + 0]; v[1] = ALPHA * v[1] + acc[mi][ni][q * 4 + 1];
          v[2] = ALPHA * v[2] + acc[mi][ni][q * 4 + 2]; v[3] = ALPHA * v[3] + acc[mi][ni][q * 4 + 3];
          *(f32x4*)hp = v;
        }
      asm volatile("" ::: "memory");
    }
  }
}

__device__ void up_phase(const Params& p, char* lds) {
  const int lane = tidx() & 63, wave = tidx() >> 6, wm = wave >> 2, wn = wave & 3;
  for (int t = bidx(); t < 128 * 16; t += gridDim.x) {
    const int mt = t >> 4, nt = t & 15;
    f32x16 acc[4][2];
    zero_acc<4, 2>(acc);
    gemm_mainloop<4, 2>(p.hb + (size_t)mt * 256 * DM, DM, p.WupT + (size_t)nt * 256 * DM, DM, DM, lds, acc);
#pragma unroll
    for (int mi = 0; mi < 4; ++mi) {
      const int m = mt * 256 + wm * 128 + mi * 32 + (lane & 31);
#pragma unroll
      for (int ni = 0; ni < 2; ++ni)
#pragma unroll
        for (int q = 0; q < 4; ++q) {
          const int n = nt * 256 + wn * 64 + ni * 32 + q * 8 + (lane >> 5) * 4;
          float r0 = fmaxf(acc[mi][ni][q * 4 + 0], 0.f), r1 = fmaxf(acc[mi][ni][q * 4 + 1], 0.f), r2 = fmaxf(acc[mi][ni][q * 4 + 2], 0.f), r3 = fmaxf(acc[mi][ni][q * 4 + 3], 0.f);
          u32x2 w; w.x = pk_bf16(r0 * r0, r1 * r1); w.y = pk_bf16(r2 * r2, r3 * r3);
          *(u32x2*)(p.U + (size_t)m * DFF + n) = w;
        }
    }
  }
}


#ifndef DBG_STOP
#define DBG_STOP 0
#endif
#ifndef DBG_QMASK
#define DBG_QMASK 1
#endif
__device__ void dbg_dump(const Params& p, int which) {
  const int tid = tidx();
  for (int m = bidx(); m < MTOK; m += (int)gridDim.x) {
    for (int n = tid; n < 1024; n += NT) {
      float v = 0.f;
      if (which == 1) {
        v = bf2f(p.Z[(size_t)m * 512 + (n & 511)]) + bf2f(p.XBC[(size_t)m * 1024 + n]) + bf2f(p.DNQKV[(size_t)m * 1536 + n]) + bf2f(p.DNQKV[(size_t)m * 1536 + 512 + n])
          + bf2f(p.DNG[(size_t)m * 512 + (n & 511)]) + bf2f(p.SGUV[(size_t)m * 1024 + n]) + bf2f(p.FOXQKV[(size_t)m * 1536 + n]) + bf2f(p.FOXQKV[(size_t)m * 1536 + 512 + n]) + p.small[(size_t)m * 32 + (n & 31)];
      } else if (which == 2) {
        v = p.cbuf[(size_t)(m >> 12) * 8 * SEQL + (size_t)(n & 7) * SEQL + (m & 4095)];
      } else if (which == 3) {
        const int q = n >> 8, c = n & 255;
        if (!((DBG_QMASK >> q) & 1)) { p.hf[(size_t)m * DM + n] = 1.f; continue; }
        if (q == 0) v = bf2f(p.Z[(size_t)m * 512 + c]) + bf2f(p.Z[(size_t)m * 512 + 256 + c]) + p.ssqp[(size_t)(c & 7) * MTOK + m];
        else if (q == 1) v = bf2f(p.DNG[(size_t)m * 512 + c]) + bf2f(p.DNG[(size_t)m * 512 + 256 + c]);
        else if (q == 2) v = bf2f(p.SGUV[(size_t)m * 1024 + c]) + bf2f(p.SGUV[(size_t)m * 1024 + 256 + c]);
        else v = bf2f(p.FOXQKV[(size_t)m * 1536 + c]) + bf2f(p.FOXQKV[(size_t)m * 1536 + 256 + c]);
      } else if (which == 4) {
        v = bf2f(p.XBC[(size_t)m * 1024 + n]);
      } else if (which == 7) {
        v = bf2f(p.U[(size_t)m * 4096 + n]) + bf2f(p.U[(size_t)m * 4096 + 1024 + n]) + bf2f(p.U[(size_t)m * 4096 + 2048 + n]) + bf2f(p.U[(size_t)m * 4096 + 3072 + n]);
      }
      p.hf[(size_t)m * DM + n] = v;
    }
  }
}
#define LAS __attribute__((address_space(3)))
#define XB_TMO      128
#define XB_XCNT(j)  (256  + 64 * (j))
#define XB_XSUB(j)  (1280 + 64 * (j))
#define XB_XGEN(j)  (2304 + 64 * (j))
#define XB_TOP      3328
#define XB_TOPGEN   3392
#define XCD_BAR_WORDS 3456
#define XB_SPIN_CAP (1u << 18)

__device__ __forceinline__ unsigned xb_ld(unsigned* p)              { return __hip_atomic_load(p, __ATOMIC_RELAXED, __HIP_MEMORY_SCOPE_AGENT); }
__device__ __forceinline__ unsigned xb_add(unsigned* p, unsigned v) { return __hip_atomic_fetch_add(p, v, __ATOMIC_RELAXED, __HIP_MEMORY_SCOPE_AGENT); }
__device__ __forceinline__ unsigned xb_xcc_id() { return (unsigned)__builtin_amdgcn_s_getreg((3 << 11) | 20) & 0xFu; }
#define XB_SPIN(cond, bar) do { unsigned _sp = 0; while (cond) { __builtin_amdgcn_s_sleep(1); \
    if ((++_sp & 255u) == 0u) { if (xb_ld(&(bar)[XB_TMO])) break; if (_sp > XB_SPIN_CAP) { atomicAdd(&(bar)[XB_TMO], 1u); break; } } } } while (0)

struct XcdBarrier {
    unsigned* bar; unsigned x;
    volatile LAS unsigned* st;
};

__device__ __forceinline__ XcdBarrier xcd_barrier_post(unsigned* bar, volatile LAS unsigned* st) {
    XcdBarrier b; b.bar = bar; b.x = xb_xcc_id(); b.st = st;
    if (threadIdx.x == 0) (void)xb_add(&bar[XB_XCNT(b.x)], 1u);
    return b;
}
__device__ __forceinline__ void xcd_barrier_complete(unsigned* bar, unsigned x, unsigned& nloc, unsigned& nx) {
    const unsigned G = gridDim.x * gridDim.y * gridDim.z;
    unsigned sum, cnt, mine, sp = 0u;
    for (;;) {
        sum = 0u; cnt = 0u; mine = 0u;
#pragma unroll
        for (unsigned j = 0; j < 16; ++j) { const unsigned c = xb_ld(&bar[XB_XCNT(j)]); sum += c; cnt += (c > 0u) ? 1u : 0u; mine = (j == x) ? c : mine; }
        if (sum == G) break;
        __builtin_amdgcn_s_sleep(1);
        if ((++sp & 255u) == 0u) { if (xb_ld(&bar[XB_TMO])) break; if (sp > XB_SPIN_CAP) { atomicAdd(&bar[XB_TMO], 1u); break; } }
    }
    nloc = mine > 0u ? mine : 1u; nx = cnt > 0u ? cnt : 1u;
}

__device__ __forceinline__ void xcd_barrier(const XcdBarrier& b) {
    asm volatile("s_waitcnt vmcnt(0)" ::: "memory");
    __syncthreads();
    if (threadIdx.x == 0) {
        unsigned* bar = b.bar;
        __builtin_amdgcn_s_waitcnt(0);
        unsigned nloc = b.st[0], nx = b.st[1];
        if (nloc == 0u) { xcd_barrier_complete(bar, b.x, nloc, nx); b.st[0] = nloc; b.st[1] = nx; }
        const unsigned old = xb_add(&bar[XB_XSUB(b.x)], 1u);
        const unsigned gen = old / nloc;
        if (old + 1u == (gen + 1u) * nloc) {
            __builtin_amdgcn_fence(__ATOMIC_RELEASE, "agent");
            asm volatile("s_waitcnt vmcnt(0)" ::: "memory");
            const unsigned og = xb_add(&bar[XB_TOP], 1u);
            const unsigned tg = og / nx;
            if (og + 1u == (tg + 1u) * nx) xb_add(&bar[XB_TOPGEN], 1u);
            else XB_SPIN(xb_ld(&bar[XB_TOPGEN]) == tg, bar);
            __builtin_amdgcn_fence(__ATOMIC_ACQUIRE, "agent");
            xb_add(&bar[XB_XGEN(b.x)], 1u);
            asm volatile("s_waitcnt vmcnt(0)" ::: "memory");
        } else {
            XB_SPIN(xb_ld(&bar[XB_XGEN(b.x)]) == gen, bar);
            __builtin_amdgcn_fence(__ATOMIC_ACQUIRE, "agent");
            asm volatile("s_waitcnt vmcnt(0)" ::: "memory");
        }
    }
    __syncthreads();
}

#define CG_SYNC() do { asm volatile("s_waitcnt vmcnt(0) lgkmcnt(0)" ::: "memory"); grid.sync(); } while (0)
#define GRID_SYNC() xcd_barrier(xb)
__global__ void __launch_bounds__(NT) hybrid_fwd(Params p) {
  extern __shared__ __attribute__((aligned(16))) char smem[];
  cg::grid_group grid = cg::this_grid();
  int* s_item = (int*)smem;
  char* lds = smem + 64;
  PG8_LAS unsigned char* lds3 = (PG8_LAS unsigned char*)smem + 1024;
  volatile LAS unsigned* xst = (volatile LAS unsigned*)((LAS unsigned char*)smem + 16);
  if (threadIdx.x == 0) { xst[0] = 0u; xst[1] = 0u; }
  __syncthreads();
  const XcdBarrier xb = xcd_barrier_post(p.ctrl, xst);
  ln_phase(p.x, nullptr, p.hb, p.ln_in_g, p.ln_in_b);
  convert_weights(p, 0, lds);
  CG_SYNC();
  for (int layer = 0; layer < 2; ++layer) {
    { EpiProj E; E.p = p; pg8_phase(p.hb, p.WinT, NPROJ, DM, E, lds3); }
    GRID_SYNC();
    if (DBG_STOP == 1) { dbg_dump(p, 1); return; }
    conv_phase(p, layer);
    gates_halo_phase(p, layer);
    foxc_phase(p, layer, lds);
    GRID_SYNC();
    if (DBG_STOP == 2) { dbg_dump(p, 2); return; }
    mixer_phase1(p, layer, lds);
    GRID_SYNC();
    mixer_phase2(p, layer, lds, s_item);
    GRID_SYNC();
    if (DBG_STOP == 3) { dbg_dump(p, 3); return; }
    merge_phase(p, layer, lds3);
    GRID_SYNC();
    if (DBG_STOP == 4) { dbg_dump(p, 4); return; }
    { EpiResid E; E.hf = p.hf; E.hb = p.hb; pg8_phase(p.XBC, p.WoT, DM, DM, E, lds3); }
    GRID_SYNC();
    if (DBG_STOP == 5) return;
    ln_phase(p.hf, nullptr, p.hb, p.ln1_g + layer * DM, p.ln1_b + layer * DM);
    GRID_SYNC();
    if (DBG_STOP == 6) return;
    { EpiUp E; E.U = p.U; pg8_phase(p.hb, p.WupT, DFF, DM, E, lds3); }
    GRID_SYNC();
    if (DBG_STOP == 7) { dbg_dump(p, 7); return; }
    { EpiResid E; E.hf = p.hf; E.hb = p.hb; pg8_phase(p.U, p.WdnT, DM, DFF, E, lds3); }
    GRID_SYNC();
    if (DBG_STOP == 8) return;
    ln_phase(p.hf, layer == 1 ? p.hf : nullptr, p.hb, p.ln2_g + layer * DM, p.ln2_b + layer * DM);
    if (DBG_STOP == 9) return;
    if (layer == 0) { convert_weights(p, 1, lds); GRID_SYNC(); }
  }
}

extern "C" void kernel_launch(void* const* d_in, const int* in_sizes, int n_in, void* d_out, int out_size, void* d_ws, size_t ws_size, hipStream_t stream) {
  (void)in_sizes; (void)n_in; (void)out_size;
  Params p{};
  const float* const* in = (const float* const*)d_in;
  p.x = in[0]; p.ln_in_g = in[1]; p.ln_in_b = in[2]; p.w_in = in[3];
  p.ssd_conv_w = in[4]; p.ssd_conv_b = in[5]; p.ssd_dt_bias = in[6]; p.ssd_a_log = in[7]; p.ssd_d = in[8]; p.ssd_norm_w = in[9];
  p.dn_conv_w = in[10]; p.dn_a_log = in[11]; p.dn_dt_bias = in[12]; p.dn_norm_w = in[13];
  p.sg_ln_g = in[14]; p.sg_ln_b = in[15]; p.sg_w = in[16]; p.sg_b = in[17];
  p.fox_f_bias = in[18]; p.gate_b = in[19]; p.w_branch = in[20]; p.w_out = in[21];
  p.ln1_g = in[22]; p.ln1_b = in[23]; p.w_up = in[24]; p.w_down = in[25]; p.ln2_g = in[26]; p.ln2_b = in[27];
  p.hf = (float*)d_out;
  char* ws = (char*)d_ws;
  size_t off = 0;
  auto take = [&](size_t bytes) { char* r = ws + off; off += (bytes + 255) & ~(size_t)255; return r; };
  p.ctrl = (unsigned*)take(16384);
  p.hb = (bf16_t*)take((size_t)MTOK * 1024 * 2);
  char* seg0 = ws + off;
  p.Z = (bf16_t*)take((size_t)MTOK * 512 * 2);
  p.XBC = (bf16_t*)take((size_t)MTOK * 1024 * 2);
  p.DNQKV = (bf16_t*)take((size_t)MTOK * 1536 * 2);
  p.DNG = (bf16_t*)take((size_t)MTOK * 512 * 2);
  p.SGUV = (bf16_t*)take((size_t)MTOK * 1024 * 2);
  p.FOXQKV = (bf16_t*)take((size_t)MTOK * 1536 * 2);
  p.U = (bf16_t*)seg0;
  p.small = (float*)take((size_t)MTOK * 32 * 4);
  p.cbuf = (float*)take((size_t)64 * SEQL * 4);
  p.ssqp = (float*)take((size_t)MTOK * 8 * 4);
  p.halo = (bf16_t*)take((size_t)512 * 3 * 2560 * 2);
  p.WinT = (bf16_t*)take((size_t)NWIN * 1024 * 2);
  p.WbT = (bf16_t*)take((size_t)4 * 1024 * 512 * 2);
  p.WoT = (bf16_t*)take((size_t)1024 * 1024 * 2);
  p.WupT = (bf16_t*)take((size_t)4096 * 1024 * 2);
  p.WdnT = (bf16_t*)take((size_t)1024 * 4096 * 2);
  if (off > ws_size) { fprintf(stderr, "workspace too small: need %zu have %zu\n", off, ws_size); return; }
  static int grid_blocks = 0;
  if (!grid_blocks) {
    hipFuncSetAttribute((const void*)hybrid_fwd, hipFuncAttributeMaxDynamicSharedMemorySize, (int)LDS_BYTES);
    int dev = 0, cus = 0, per_cu = 0;
    hipGetDevice(&dev);
    hipDeviceGetAttribute(&cus, hipDeviceAttributeMultiprocessorCount, dev);
    hipOccupancyMaxActiveBlocksPerMultiprocessor(&per_cu, hybrid_fwd, NT, LDS_BYTES);
    if (per_cu < 1) per_cu = 1;
    grid_blocks = cus * per_cu;
  }
  hipMemsetAsync(p.ctrl, 0, 16384, stream);
  void* args[] = {&p};
  hipError_t e = hipLaunchCooperativeKernel((void*)hybrid_fwd, dim3(grid_blocks), dim3(NT), args, LDS_BYTES, stream);
  if (e != hipSuccess) fprintf(stderr, "cooperative launch failed: %s (grid %d)\n", hipGetErrorString(e), grid_blocks);
}
```
